# Optimizing an MI355X kernel written in HIP

```python
import math
import jax, jax.numpy as jnp
from jax import lax
import numpy as np

D_MODEL = 1024
BATCH = 4
SEQ = 4096
DEPTH = 2

POOL_WIDTH = 256
POOL_GROUPS = 4
POOL_WINDOWS = (2, 4, 8, 16)
POOL_GROUP_DIM = POOL_WIDTH // POOL_GROUPS
HGRN_HEADS = 4
HGRN_DK = 64
HGRN_DV = 64
HGRN_WIDTH = HGRN_HEADS * HGRN_DV
HGRN_CHUNK = 64
MIN_F = 1e-20
CONV_WIDTH = 256
CONV_K = 3
DIFF_HEADS = 4
DIFF_DH = 64
DIFF_WIDTH = DIFF_HEADS * 2 * DIFF_DH
Q_BLOCK = 128

N_BRANCH = 4
EPS = 1e-6
NEG = -1e30

IN_SPLITS = (
    POOL_WIDTH, POOL_WIDTH,
    HGRN_HEADS * HGRN_DK, HGRN_HEADS * HGRN_DK, HGRN_WIDTH, HGRN_WIDTH,
    CONV_WIDTH, CONV_WIDTH, CONV_WIDTH, CONV_WIDTH,
    DIFF_WIDTH, DIFF_WIDTH, DIFF_WIDTH, DIFF_WIDTH,
    N_BRANCH * D_MODEL,
)
D_IN = sum(IN_SPLITS)
IN_OFFSETS = tuple(int(v) for v in np.cumsum(IN_SPLITS)[:-1])

kernel_name = "hybrid_pool_hgrn2_conv_diffattn_block"


def rmsnorm(x, g):
    xf = x.astype(jnp.float32)
    y = xf * lax.rsqrt(jnp.mean(xf * xf, axis=-1, keepdims=True) + EPS)
    return (y * g.astype(jnp.float32)).astype(x.dtype)


def pool_mixer(a, pool_w, pool_scale):
    B_, T, _ = a.shape
    af = a.astype(jnp.float32).reshape(B_, T, POOL_GROUPS, POOL_GROUP_DIM)
    cs = jnp.concatenate([jnp.zeros_like(af[:, :1]), jnp.cumsum(af, axis=1)], axis=1)
    pos = jnp.arange(T)
    outs = []
    for gi, w in enumerate(POOL_WINDOWS):
        hi = cs[:, 1:, gi]
        lo = jnp.concatenate([jnp.zeros((B_, w - 1, POOL_GROUP_DIM), jnp.float32),
                              cs[:, :T - w + 1, gi]], axis=1)
        count = jnp.minimum(pos + 1, w).astype(jnp.float32)[None, :, None]
        outs.append((hi - lo) / count - af[:, :, gi])
    pooled = jnp.stack(outs, axis=2)
    mixed = jnp.einsum('btgc,gcd->btgd', pooled, pool_w.astype(jnp.float32))
    y = mixed.reshape(B_, T, POOL_WIDTH) * pool_scale.astype(jnp.float32)
    return y.astype(a.dtype)


def hgrn2_mixer(q, zf, v, lb, norm_g):
    B_, T, _ = q.shape
    f32 = jnp.float32
    nc = T // HGRN_CHUNK
    lbf = lb.astype(f32)
    z = zf.astype(f32)
    f = lbf + (1.0 - lbf) * jax.nn.sigmoid(z)
    log_f = jnp.log(jnp.maximum(f, MIN_F))
    k = (1.0 - lbf) * jax.nn.sigmoid(-z)
    qf = jax.nn.silu(q.astype(f32))

    def to_chunks(t, d):
        return t.reshape(B_, nc, HGRN_CHUNK, HGRN_HEADS, d).transpose(1, 0, 3, 2, 4)

    xs = (to_chunks(qf, HGRN_DK), to_chunks(k, HGRN_DK),
          to_chunks(v.astype(f32), HGRN_DV), to_chunks(log_f, HGRN_DK))
    causal = jnp.tril(jnp.ones((HGRN_CHUNK, HGRN_CHUNK), bool))[:, :, None]

    def step(S, inp):
        qc, kc, vc, gc = inp
        b = jnp.cumsum(gc, axis=2)
        o_inter = jnp.einsum('bhtk,bhkv->bhtv', qc * jnp.exp(b), S)
        diff = b[:, :, :, None, :] - b[:, :, None, :, :]
        decay = jnp.exp(jnp.where(causal, diff, NEG))
        scores = jnp.einsum('bhtk,bhtsk,bhsk->bhts', qc, decay, kc)
        o = o_inter + jnp.einsum('bhts,bhsv->bhtv', scores, vc)
        b_last = b[:, :, -1:, :]
        S_new = (jnp.exp(b_last[:, :, 0, :])[..., None] * S
                 + jnp.einsum('bhsk,bhsv->bhkv', kc * jnp.exp(b_last - b), vc))
        return S_new, o

    S0 = jnp.zeros((B_, HGRN_HEADS, HGRN_DK, HGRN_DV), f32)
    _, o = lax.scan(step, S0, xs)
    o = o.transpose(1, 0, 3, 2, 4).reshape(B_, T, HGRN_HEADS, HGRN_DV)
    o = rmsnorm(o, norm_g)
    return o.reshape(B_, T, HGRN_WIDTH).astype(q.dtype)


def short_conv_mixer(u, gate_b, gate_c, conv_w):
    z = gate_c * u
    y = lax.conv_general_dilated(z, conv_w[:, None, :], window_strides=(1,),
                                 padding=[(CONV_K - 1, 0)],
                                 dimension_numbers=('NWC', 'WIO', 'NWC'),
                                 feature_group_count=CONV_WIDTH)
    return gate_b * y


def diff_attention(q, k, v, lam, norm_g, layer_idx):
    B_, T, _ = q.shape
    f32 = jnp.float32
    q = q.reshape(B_, T, DIFF_HEADS, 2, DIFF_DH)
    k = k.reshape(B_, T, DIFF_HEADS, 2, DIFF_DH)
    v = v.reshape(B_, T, DIFF_HEADS, 2 * DIFF_DH)
    lam_init = 0.8 - 0.6 * math.exp(-0.3 * layer_idx)
    lf = lam.astype(f32)
    lam_full = jnp.exp(jnp.sum(lf[0] * lf[1])) - jnp.exp(jnp.sum(lf[2] * lf[3])) + lam_init
    scale = DIFF_DH ** -0.5
    qpos = jnp.arange(Q_BLOCK)
    outs = []
    for i in range(T // Q_BLOCK):
        L = (i + 1) * Q_BLOCK
        qb = q[:, i * Q_BLOCK:L]
        s = jnp.einsum('bqhmd,bkhmd->bhmqk', qb, k[:, :L]).astype(f32) * scale
        mask = jnp.arange(L)[None, :] <= (i * Q_BLOCK + qpos)[:, None]
        p = jax.nn.softmax(jnp.where(mask, s, NEG), axis=-1)
        a = p[:, :, 0] - lam_full * p[:, :, 1]
        outs.append(jnp.einsum('bhqk,bkhe->bqhe', a.astype(v.dtype), v[:, :L]))
    o = jnp.concatenate(outs, axis=1)
    o = rmsnorm(o, norm_g) * (1.0 - lam_init)
    return o.reshape(B_, T, DIFF_WIDTH)


def setup_inputs(seed: int = 0) -> dict:
    key = jax.random.key(seed)
    ks = jax.random.split(key, 20)

    def nrm(k, shape, s):
        return jax.random.normal(k, shape, jnp.float32) * s

    D = D_MODEL
    return {
        "x": nrm(ks[0], (BATCH, SEQ, D), 1.0),
        "c": nrm(ks[1], (BATCH, D), 1.0),
        "w_ada": nrm(ks[2], (DEPTH, D, 3 * D), 0.5 * D ** -0.5),
        "b_ada": nrm(ks[3], (DEPTH, 3 * D), 0.02),
        "g_pre": 1.0 + nrm(ks[4], (DEPTH, D), 0.1),
        "g_post": 1.0 + nrm(ks[5], (DEPTH, D), 0.1),
        "w_in": nrm(ks[6], (DEPTH, D, D_IN), D ** -0.5),
        "pool_w": nrm(ks[7], (DEPTH, POOL_GROUPS, POOL_GROUP_DIM, POOL_GROUP_DIM), POOL_GROUP_DIM ** -0.5),
        "pool_scale": 1.0 + nrm(ks[8], (DEPTH, POOL_WIDTH), 0.1),
        "hgrn_lb": nrm(ks[9], (DEPTH, HGRN_HEADS * HGRN_DK), 1.0),
        "hgrn_norm": 1.0 + nrm(ks[10], (DEPTH, HGRN_DV), 0.1),
        "conv_w": nrm(ks[11], (DEPTH, CONV_K, CONV_WIDTH), CONV_K ** -0.5),
        "diff_lam": nrm(ks[12], (DEPTH, 4, DIFF_DH), 0.1),
        "diff_norm": 1.0 + nrm(ks[13], (DEPTH, 2 * DIFF_DH), 0.1),
        "w_merge_pool": nrm(ks[14], (DEPTH, POOL_WIDTH, D), POOL_WIDTH ** -0.5),
        "w_merge_hgrn": nrm(ks[15], (DEPTH, HGRN_WIDTH, D), HGRN_WIDTH ** -0.5),
        "w_merge_conv": nrm(ks[16], (DEPTH, CONV_WIDTH, D), CONV_WIDTH ** -0.5),
        "w_merge_diff": nrm(ks[17], (DEPTH, DIFF_WIDTH, D), DIFF_WIDTH ** -0.5),
        "w_out": nrm(ks[18], (DEPTH, D, D), D ** -0.5),
    }


def reference(x, c, w_ada, b_ada, g_pre, g_post, w_in, pool_w, pool_scale, hgrn_lb,
              hgrn_norm, conv_w, diff_lam, diff_norm, w_merge_pool, w_merge_hgrn,
              w_merge_conv, w_merge_diff, w_out):
    B_, T, D = x.shape
    c_act = jax.nn.silu(c)
    lb_sm = jax.nn.softmax(hgrn_lb.astype(jnp.float32), axis=0)
    lower_bounds = jnp.cumsum(lb_sm, axis=0) - lb_sm[0]
    for l in range(DEPTH):
        mod = c_act @ w_ada[l] + b_ada[l]
        shift, scale, gate = jnp.split(mod, 3, axis=-1)
        h = rmsnorm(x, g_pre[l]) * (1.0 + scale[:, None]) + shift[:, None]
        p = h @ w_in[l]
        (a_in, a_g, b_q, b_f, b_i, b_g, c_x, c_b, c_c, c_g,
         d_q, d_k, d_v, d_g, m_g) = jnp.split(p, IN_OFFSETS, axis=-1)

        y_pool = pool_mixer(a_in, pool_w[l], pool_scale[l]) * jax.nn.silu(a_g)
        y_hgrn = hgrn2_mixer(b_q, b_f, b_i, lower_bounds[l], hgrn_norm[l]) * jax.nn.silu(b_g)
        y_conv = short_conv_mixer(c_x, c_b, c_c, conv_w[l]) * jax.nn.silu(c_g)
        y_diff = diff_attention(d_q, d_k, d_v, diff_lam[l], diff_norm[l], l) * jax.nn.silu(d_g)

        gates = jax.nn.sigmoid(m_g.reshape(B_, T, N_BRANCH, D))
        merged = (gates[:, :, 0] * (y_pool @ w_merge_pool[l])
                  + gates[:, :, 1] * (y_hgrn @ w_merge_hgrn[l])
                  + gates[:, :, 2] * (y_conv @ w_merge_conv[l])
                  + gates[:, :, 3] * (y_diff @ w_merge_diff[l]))
        out = merged @ w_out[l]
        x = x + gate[:, None] * rmsnorm(out, g_post[l])
    return x
```

```cpp
#include <hip/hip_runtime.h>
#include <hip/hip_cooperative_groups.h>
#include <hip/hip_bf16.h>
#include <cstdio>
#include <cstdint>
#include <cmath>
namespace cg = cooperative_groups;

#ifndef MK_MULTI
#define MK_MULTI 0
#endif

#define LAS __attribute__((address_space(3)))
typedef unsigned short bf16_t;
typedef short bf16x8 __attribute__((ext_vector_type(8)));
typedef float f32x4 __attribute__((ext_vector_type(4)));
typedef unsigned u32x4 __attribute__((ext_vector_type(4)));
typedef unsigned u32x2 __attribute__((ext_vector_type(2)));

constexpr int M = 16384, SEQ = 4096, D = 1024, DIN = 8704, NP = 4608;
constexpr int C_AIN = 0, C_AG = 256, C_BQ = 512, C_BF = 768, C_BI = 1024, C_BG = 1280, C_CX = 1536, C_CB = 1792, C_CC = 2048, C_CG = 2304,
              C_DQ = 2560, C_DK = 3072, C_DV = 3584, C_DG = 4096, C_MG = 4608;
constexpr float EPS = 1e-6f;
constexpr int NTHR = 512, NWAVES = 8;
constexpr int LDS_BYTES = 147456;
constexpr size_t MiB = 1u << 20;
constexpr size_t WS_MOD = 0, WS_BAR = 128 * 1024, WS_DEC = 256 * 1024;
constexpr size_t WS_WIN = 1 * MiB, WS_WMRG = 18 * MiB  , WS_WOUT = 22 * MiB, WS_H = 24 * MiB, WS_O = 56 * MiB, WS_S = 88 * MiB, WS_P = 104 * MiB, WS_TAIL = 248 * MiB, WS_END = 256 * MiB;

__device__ __forceinline__ float bf2f(unsigned u) { return __uint_as_float(u << 16); }
__device__ __forceinline__ unsigned f2bf(float f) { unsigned u = __float_as_uint(f); return (u + 0x7fffu + ((u >> 16) & 1u)) >> 16; }
__device__ __forceinline__ unsigned pk2(float lo, float hi) { return f2bf(lo) | (f2bf(hi) << 16); }
__device__ __forceinline__ void unpack8(const u32x4 w, float (&f)[8]) {
    f[0] = __uint_as_float(w.x << 16); f[1] = __uint_as_float(w.x & 0xffff0000u); f[2] = __uint_as_float(w.y << 16); f[3] = __uint_as_float(w.y & 0xffff0000u);
    f[4] = __uint_as_float(w.z << 16); f[5] = __uint_as_float(w.z & 0xffff0000u); f[6] = __uint_as_float(w.w << 16); f[7] = __uint_as_float(w.w & 0xffff0000u);
}
__device__ __forceinline__ u32x4 pack8(const float (&f)[8]) { u32x4 w; w.x = pk2(f[0], f[1]); w.y = pk2(f[2], f[3]); w.z = pk2(f[4], f[5]); w.w = pk2(f[6], f[7]); return w; }
__device__ __forceinline__ void load8(const bf16_t* p, float (&f)[8]) { const u32x4 w = *(const u32x4*)p; unpack8(w, f); }
__device__ __forceinline__ float sigmoidf_(float x) { return __builtin_amdgcn_rcpf(1.0f + __builtin_amdgcn_exp2f(-1.4426950408889634f * x)); }
__device__ __forceinline__ float siluf_(float x) { return x * sigmoidf_(x); }
__device__ __forceinline__ float shflx(float v, int mask, int lane) { return __int_as_float(__builtin_amdgcn_ds_bpermute((lane ^ mask) << 2, __float_as_int(v))); }
__device__ __forceinline__ float wave_sum(float v, int lane) {
#pragma unroll
    for (int o = 1; o < 64; o <<= 1) v += shflx(v, o, lane);
    return v;
}
__device__ __forceinline__ int tsw(int row, int col) { return row * 72 + ((((col >> 3) ^ ((row >> 3) & 7)) << 3) | (col & 7)); }
__device__ __forceinline__ void cumsum64(LAS float* LF, int tid, int lane) {
    const int k = tid >> 3, seg = tid & 7; float v[8]; float run = 0.f;
#pragma unroll
    for (int i = 0; i < 8; ++i) { run += LF[(8 * seg + i) * 65 + k]; v[i] = run; }
    float inc = run;
#pragma unroll
    for (int d = 1; d < 8; d <<= 1) { const float o = __int_as_float(__builtin_amdgcn_ds_bpermute((lane - d) << 2, __float_as_int(inc))); if (seg >= d) inc += o; }
    const float off = inc - run;
#pragma unroll
    for (int i = 0; i < 8; ++i) LF[(8 * seg + i) * 65 + k] = v[i] + off;
}
#define XB_TMO      128
#define XB_XCNT(j)  (256  + 64 * (j))
#define XB_XSUB(j)  (1280 + 64 * (j))
#define XB_XGEN(j)  (2304 + 64 * (j))
#define XB_TOP      3328
#define XB_TOPGEN   3392
#define XCD_BAR_WORDS 3456
#define XB_SPIN_CAP (1u << 18)

__device__ __forceinline__ unsigned xb_ld(unsigned* p)              { return __hip_atomic_load(p, __ATOMIC_RELAXED, __HIP_MEMORY_SCOPE_AGENT); }
__device__ __forceinline__ unsigned xb_add(unsigned* p, unsigned v) { return __hip_atomic_fetch_add(p, v, __ATOMIC_RELAXED, __HIP_MEMORY_SCOPE_AGENT); }
__device__ __forceinline__ unsigned xb_xcc_id() { return (unsigned)__builtin_amdgcn_s_getreg((3 << 11) | 20) & 0xFu; }
#define XB_SPIN(cond, bar) do { unsigned _sp = 0; while (cond) { __builtin_amdgcn_s_sleep(1); \
    if ((++_sp & 255u) == 0u) { if (xb_ld(&(bar)[XB_TMO])) break; if (_sp > XB_SPIN_CAP) { atomicAdd(&(bar)[XB_TMO], 1u); break; } } } } while (0)

struct XcdBarrier {
    unsigned* bar; unsigned x;
    volatile LAS unsigned* st;
};

__device__ __forceinline__ XcdBarrier xcd_barrier_post(unsigned* bar, volatile LAS unsigned* st, int tid) {
    XcdBarrier b; b.bar = bar; b.x = xb_xcc_id(); b.st = st;
    if (tid == 0) (void)xb_add(&bar[XB_XCNT(b.x)], 1u);
    return b;
}
__device__ __forceinline__ void xcd_barrier_complete(unsigned* bar, unsigned x, unsigned& nloc, unsigned& nx) {
    const unsigned G = gridDim.x * gridDim.y * gridDim.z;
    unsigned sum, cnt, mine, sp = 0u;
    for (;;) {
        sum = 0u; cnt = 0u; mine = 0u;
#pragma unroll
        for (unsigned j = 0; j < 16; ++j) { const unsigned c = xb_ld(&bar[XB_XCNT(j)]); sum += c; cnt += (c > 0u) ? 1u : 0u; mine = (j == x) ? c : mine; }
        if (sum == G) break;
        __builtin_amdgcn_s_sleep(1);
        if ((++sp & 255u) == 0u) { if (xb_ld(&bar[XB_TMO])) break; if (sp > XB_SPIN_CAP) { atomicAdd(&bar[XB_TMO], 1u); break; } }
    }
    nloc = mine > 0u ? mine : 1u; nx = cnt > 0u ? cnt : 1u;
}

__device__ __forceinline__ void xcd_barrier(const XcdBarrier& b, int tid) {
    asm volatile("s_waitcnt vmcnt(0)" ::: "memory");
    __syncthreads();
    if (tid == 0) {
        unsigned* bar = b.bar;
        __builtin_amdgcn_s_waitcnt(0);
        unsigned nloc = b.st[0], nx = b.st[1];
        if (nloc == 0u) { xcd_barrier_complete(bar, b.x, nloc, nx); b.st[0] = nloc; b.st[1] = nx; }
        const unsigned old = xb_add(&bar[XB_XSUB(b.x)], 1u);
        const unsigned gen = old / nloc;
        if (old + 1u == (gen + 1u) * nloc) {
            __builtin_amdgcn_fence(__ATOMIC_RELEASE, "agent");
            asm volatile("s_waitcnt vmcnt(0)" ::: "memory");
            const unsigned og = xb_add(&bar[XB_TOP], 1u);
            const unsigned tg = og / nx;
            if (og + 1u == (tg + 1u) * nx) xb_add(&bar[XB_TOPGEN], 1u);
            else XB_SPIN(xb_ld(&bar[XB_TOPGEN]) == tg, bar);
            __builtin_amdgcn_fence(__ATOMIC_ACQUIRE, "agent");
            xb_add(&bar[XB_XGEN(b.x)], 1u);
            asm volatile("s_waitcnt vmcnt(0)" ::: "memory");
        } else {
            XB_SPIN(xb_ld(&bar[XB_XGEN(b.x)]) == gen, bar);
            __builtin_amdgcn_fence(__ATOMIC_ACQUIRE, "agent");
            asm volatile("s_waitcnt vmcnt(0)" ::: "memory");
        }
    }
    __syncthreads();
}

__device__ __forceinline__ int win_row(int n) { if (n < 4608) return n; const int g = n - 4608, b = g >> 10, d = g & 1023; return 4608 + 256 * (d >> 6) + 128 * (b >> 1) + 32 * ((d >> 4) & 3) + 16 * (b & 1) + (d & 15); }
template <bool PERMW, int PITCH = 0>
__device__ __forceinline__ void transpose_item(const float* W, int K, int N, bf16_t* WT, LAS float* scr, int item, int lane) {
    const int nblk = N / 32, kb = item / nblk, nb = item % nblk, k0 = 64 * kb, n0 = 32 * nb;
#pragma unroll 8
    for (int i = 0; i < 32; ++i) { const int kk = 2 * i + (lane >> 5); scr[kk * 33 + (lane & 31)] = __builtin_nontemporal_load(W + (size_t)(k0 + kk) * N + n0 + (lane & 31)); }
    asm volatile("s_waitcnt lgkmcnt(0)" ::: "memory");
    const int c = lane & 7;
#pragma unroll
    for (int j = 0; j < 4; ++j) { const int n = (lane >> 3) + 8 * j; const LAS float* s = scr + (8 * c) * 33 + n;
        u32x4 o; o.x = pk2(s[0 * 33], s[1 * 33]); o.y = pk2(s[2 * 33], s[3 * 33]); o.z = pk2(s[4 * 33], s[5 * 33]); o.w = pk2(s[6 * 33], s[7 * 33]);
        *(u32x4*)(WT + (size_t)(PERMW ? win_row(n0 + n) : (n0 + n)) * (PITCH ? PITCH : K) + k0 + 8 * c) = o; }
    asm volatile("s_waitcnt lgkmcnt(0)" ::: "memory");
}

namespace pg8 {
#define PG8_LAS __attribute__((address_space(3)))
typedef unsigned short bf16_t;
typedef short bf16x8 __attribute__((ext_vector_type(8)));
typedef float f32x4 __attribute__((ext_vector_type(4)));
typedef unsigned u32x4 __attribute__((ext_vector_type(4)));
constexpr int BM = 256, BK = 64, HALF = 128, HTB = HALF * BK * 2  , STAGE_BYTES = 8 * HTB, NXCD = 8, WGM = 8;

__host__ __device__ __forceinline__ int lds_byte(int r, int c) { const int st = (r >> 4) * 2 + (c >> 5), rr = r & 15, cc = c & 31, ob = rr * 64 + cc * 2; return st * 1024 + (ob ^ (((ob >> 9) & 1) << 5)); }
__host__ __device__ __forceinline__ void stage_rc(int b, int& R, int& C) { const int st = b / 1024, sb = b % 1024, swz = sb ^ (((sb >> 9) & 1) << 5); R = (st >> 1) * 16 + swz / 64; C = (st & 1) * 32 + (swz % 64) / 2; }
__host__ __device__ __forceinline__ int perm32(int rho) { const int n = rho >> 4, i = rho & 15; return 8 * (i >> 2) + 4 * n + (i & 3); }

typedef unsigned u32x2 __attribute__((ext_vector_type(2)));
struct Unit { int pm, pn; };
struct Gemm { const bf16_t* A; const bf16_t* Bt; int M, N, K, lda, ldb; };

struct StaticOrder {
    int nM, nN, nwg, G, c;
    __host__ __device__ void init(int M, int N, int G_, int c_) { nM = M / BM; nN = N / BM; nwg = nM * nN; G = G_; c = c_; }
    __host__ __device__ bool next(int i, Unit& u) const {
        const long L = (long)i * G + c; if (L >= nwg) return false;
        int wgid = (int)L; { const int q = nwg / NXCD, r = nwg % NXCD, xcd = wgid % NXCD, off = wgid / NXCD; wgid = (xcd < r ? xcd * (q + 1) : r * (q + 1) + (xcd - r) * q) + off; }
        const int nig = WGM * nN, gid = wgid / nig, fm = gid * WGM, gsz = (nM - fm) < WGM ? (nM - fm) : WGM;
        u.pm = fm + ((wgid % nig) % gsz); u.pn = (wgid % nig) / gsz; return true;
    }
    __device__ __forceinline__ void a_ready(const Unit&) const {}
    __device__ __forceinline__ void done(const Unit&) const {}
};


__device__ __forceinline__ bf16_t* yslot(int s, bf16_t* P, bf16_t* S2, bf16_t* T, int& pitch) {
    if (s < 13) { pitch = 4608; const int col = (s == 0) ? 0 : (s <= 3) ? 512 + 256 * (s - 1) : (s <= 6) ? 1536 + 256 * (s - 4) : 2560 + 256 * (s - 7); return P + col; }
    pitch = 256; return (s < 15) ? S2 + (size_t)(s - 13) * 16384 * 256 : T;
}

__device__ __forceinline__ unsigned cvt_pk_bf16(float lo, float hi) { unsigned r; asm volatile("v_cvt_pk_bf16_f32 %0, %1, %2" : "=v"(r) : "v"(lo), "v"(hi)); return r; }
__device__ __forceinline__ float sigm(float x) { return __builtin_amdgcn_rcpf(1.0f + __builtin_amdgcn_exp2f(-1.4426950408889634f * x)); }
struct EpiStore {
    static constexpr bool PERM = true, AFTER_DRAIN = false;
    bf16_t* O; int ldc; int q_lo, q_hi; float qscale;
    __device__ __forceinline__ void operator()(const f32x4 (&acc)[2][2][4][2], const Unit& u, int wr, int wc, int fr, int fq) const {
        const int row0 = u.pm * BM + wr * 64 + fr, colt = u.pn * BM; const bool ntst = !(colt >= q_lo && colt < q_lo + 1536);   const float sc = (colt >= q_lo && colt < q_hi) ? qscale : 1.0f;
        const int col0 = colt + wc * 32 + 8 * fq;
#pragma unroll
        for (int ai = 0; ai < 2; ++ai)
#pragma unroll
            for (int m = 0; m < 4; ++m) { bf16_t* rowp = O + (size_t)(row0 + ai * HALF + m * 16) * ldc + col0;
#pragma unroll
                for (int bj = 0; bj < 2; ++bj) { const f32x4 v0 = acc[ai][bj][m][0] * sc, v1 = acc[ai][bj][m][1] * sc;
                    u32x4 w; w.x = cvt_pk_bf16(v0[0], v0[1]); w.y = cvt_pk_bf16(v0[2], v0[3]); w.z = cvt_pk_bf16(v1[0], v1[1]); w.w = cvt_pk_bf16(v1[2], v1[3]);
                    if (ntst) __builtin_nontemporal_store(w, (u32x4*)(rowp + bj * HALF)); else *(u32x4*)(rowp + bj * HALF) = w; } }
    }
};
struct EpiY {
    static constexpr bool PERM = true, AFTER_DRAIN = false;
    bf16_t* P; bf16_t* S2; bf16_t* T;
    __device__ __forceinline__ void operator()(const f32x4 (&acc)[2][2][4][2], const Unit& u, int wr, int wc, int fr, int fq) const {
        int ldc; bf16_t* O = yslot(u.pn, P, S2, T, ldc);
        const int row0 = u.pm * BM + wr * 64 + fr, col0 = wc * 32 + 8 * fq;
#pragma unroll
        for (int ai = 0; ai < 2; ++ai)
#pragma unroll
            for (int m = 0; m < 4; ++m) { bf16_t* rowp = O + (size_t)(row0 + ai * HALF + m * 16) * ldc + col0;
#pragma unroll
                for (int bj = 0; bj < 2; ++bj) { const f32x4 v0 = acc[ai][bj][m][0], v1 = acc[ai][bj][m][1];
                    u32x4 w; w.x = cvt_pk_bf16(v0[0], v0[1]); w.y = cvt_pk_bf16(v0[2], v0[3]); w.z = cvt_pk_bf16(v1[0], v1[1]); w.w = cvt_pk_bf16(v1[2], v1[3]);
                    *(u32x4*)(rowp + bj * HALF) = w; } }
    }
};
struct EpiGate {
    static constexpr bool PERM = false, AFTER_DRAIN = false;
    bf16_t* P; bf16_t* S2; bf16_t* T; bf16_t* MRG;
    __device__ __forceinline__ void operator()(const f32x4 (&acc)[2][2][4][2], const Unit& u, int wr, int wc, int fr, int fq) const {
        const int sq = u.pn >> 2, chs = (u.pn & 3) * 64 + 16 * wc + 4 * fq;
        const bf16_t* yb[4]; int yp[4];
#pragma unroll
        for (int b = 0; b < 4; ++b) { int pitch; bf16_t* base = yslot(4 * b + sq, P, S2, T, pitch); yb[b] = base + chs; yp[b] = pitch; }
#pragma unroll
        for (int ai = 0; ai < 2; ++ai)
#pragma unroll
            for (int m = 0; m < 4; ++m) { const int row = u.pm * BM + ai * HALF + wr * 64 + m * 16 + fr; f32x4 mg = (f32x4){0.f, 0.f, 0.f, 0.f};
#pragma unroll
                for (int b = 0; b < 4; ++b) { const u32x2 y = *(const u32x2*)(yb[b] + (size_t)row * yp[b]); const f32x4 g = acc[ai][b >> 1][m][b & 1];
                    mg[0] += sigm(g[0]) * __uint_as_float(y.x << 16); mg[1] += sigm(g[1]) * __uint_as_float(y.x & 0xffff0000u);
                    mg[2] += sigm(g[2]) * __uint_as_float(y.y << 16); mg[3] += sigm(g[3]) * __uint_as_float(y.y & 0xffff0000u); }
                u32x2 w; w.x = cvt_pk_bf16(mg[0], mg[1]); w.y = cvt_pk_bf16(mg[2], mg[3]);
                *(u32x2*)(MRG + (size_t)row * 1024 + u.pn * 64 + 16 * wc + 4 * fq) = w; }
    }
};
struct EpiOut {
    static constexpr bool PERM = true, AFTER_DRAIN = false;
    bf16_t* O; float* SSQ;
    __device__ __forceinline__ void operator()(const f32x4 (&acc)[2][2][4][2], const Unit& u, int wr, int wc, int fr, int fq) const {
        const int row0 = u.pm * BM + wr * 64 + fr, col0 = u.pn * BM + wc * 32 + 8 * fq;
#pragma unroll
        for (int ai = 0; ai < 2; ++ai)
#pragma unroll
            for (int m = 0; m < 4; ++m) { const int row = row0 + ai * HALF + m * 16; bf16_t* rowp = O + (size_t)row * 1024 + col0; float ss = 0.f;
#pragma unroll
                for (int bj = 0; bj < 2; ++bj) { const f32x4 v0 = acc[ai][bj][m][0], v1 = acc[ai][bj][m][1];
                    ss += (v0[0] * v0[0] + v0[1] * v0[1]) + (v0[2] * v0[2] + v0[3] * v0[3]) + (v1[0] * v1[0] + v1[1] * v1[1]) + (v1[2] * v1[2] + v1[3] * v1[3]);
                    u32x4 w; w.x = cvt_pk_bf16(v0[0], v0[1]); w.y = cvt_pk_bf16(v0[2], v0[3]); w.z = cvt_pk_bf16(v1[0], v1[1]); w.w = cvt_pk_bf16(v1[2], v1[3]);
                    *(u32x4*)(rowp + bj * HALF) = w; }
                { const int ln = fr + 16 * fq; ss += __int_as_float(__builtin_amdgcn_ds_bpermute((ln ^ 16) << 2, __float_as_int(ss))); ss += __int_as_float(__builtin_amdgcn_ds_bpermute((ln ^ 32) << 2, __float_as_int(ss))); }
                if (fq == 0) SSQ[(size_t)row * 16 + u.pn * 4 + wc] = ss; }
    }
};
template <class Epi, class Sched, bool ALIGN_EPI = false, bool SP2 = false, bool YB = false>
__device__ __forceinline__ void gemm_phase(const int tid, PG8_LAS unsigned char* lds, const Gemm g, const Sched& S, const Epi& E) {
    const int wid = __builtin_amdgcn_readfirstlane(tid >> 6), lane = tid & 63, wr = wid >> 2, wc = wid & 3, fr = lane & 15, fq = lane >> 4;
    int nt = g.K / BK;
    unsigned voffA[2], voffB[2];
#pragma unroll
    for (int i = 0; i < 2; ++i) { int R, C; stage_rc(tid * 16 + i * 8192, R, C); const int Rb = Epi::PERM ? ((R & ~31) + perm32(R & 31)) : R;
        voffA[i] = (unsigned)(R * g.lda + C) * 2u; voffB[i] = (unsigned)(Rb * g.ldb + C) * 2u; }
    const size_t kstep = (size_t)(BK * 2);
    const size_t hstepA = (size_t)HALF * g.lda * 2, hstepB = (size_t)HALF * g.ldb * 2;
    const size_t tstepA = 2 * hstepA, tstepB = 2 * hstepB;
    const unsigned ldsw = (unsigned)wid * 1024u;
    const int aoff = lds_byte(wr * 64 + fr, fq * 8), boff = lds_byte(wc * 32 + fr, fq * 8);
#define PG8_SA(b, h) (((b) * 2 + (h)) * HTB)
#define PG8_SB(b, h) ((4 + (b) * 2 + (h)) * HTB)
#define PG8_STAGE(bufoff, gbase, voff) do { _Pragma("unroll") for (int _i = 0; _i < 2; ++_i) \
        __builtin_amdgcn_global_load_lds((const unsigned*)((const char*)(gbase) + (voff)[_i]), (PG8_LAS unsigned*)(lds + (bufoff) + ldsw + _i * 8192), 16, 0, 0); } while (0)
#define PG8_LDA(dst, b, h) do { _Pragma("unroll") for (int m = 0; m < 4; ++m) _Pragma("unroll") for (int k = 0; k < 2; ++k) dst[m][k] = *(const PG8_LAS bf16x8*)(lds + PG8_SA(b, h) + aoff + m * 2048 + k * 1024); } while (0)
#define PG8_LDB(dst, b, h) do { _Pragma("unroll") for (int n = 0; n < 2; ++n) _Pragma("unroll") for (int k = 0; k < 2; ++k) dst[n][k] = *(const PG8_LAS bf16x8*)(lds + PG8_SB(b, h) + boff + n * 2048 + k * 1024); } while (0)
#define PG8_MMA(ai, bj, At, Bt) do { __builtin_amdgcn_s_setprio(1); _Pragma("unroll") for (int m = 0; m < 4; ++m) _Pragma("unroll") for (int n = 0; n < 2; ++n) _Pragma("unroll") for (int k = 0; k < 2; ++k) \
        acc[ai][bj][m][n] = __builtin_amdgcn_mfma_f32_16x16x32_bf16(Bt[n][k], At[m][k], acc[ai][bj][m][n], 0, 0, 0); __builtin_amdgcn_s_setprio(0); } while (0)
#define PG8_WAIT_V(n) asm volatile("s_waitcnt vmcnt(" #n ")" ::: "memory")
#define PG8_WAIT_L(n) asm volatile("s_waitcnt lgkmcnt(" #n ")" ::: "memory")
#define PG8_BAR __builtin_amdgcn_s_barrier()
#define PG8_SCHED __builtin_amdgcn_sched_barrier(0)
    Unit cur, nxt; int ui = 0;
    if (!S.next(0, cur)) return;
    f32x4 acc[2][2][4][2];
#pragma unroll
    for (int a = 0; a < 2; ++a)
#pragma unroll
        for (int b = 0; b < 2; ++b)
#pragma unroll
            for (int m = 0; m < 4; ++m)
#pragma unroll
                for (int n = 0; n < 2; ++n) acc[a][b][m][n] = (f32x4){0.f, 0.f, 0.f, 0.f};
    bf16x8 At[4][2], B0[2][2], B1[2][2];
#define PG8_APTR(u) (YB ? (const char*)g.A + (size_t)(u).pm * tstepA + 2 * (((u).pn >> 2) == 0 ? 256 : ((u).pn >> 2) == 1 ? 1280 : ((u).pn >> 2) == 2 ? 2304 : 4096) : (const char*)g.A + (size_t)(u).pm * tstepA)
#define PG8_BPTR(u) (YB ? (const char*)g.Bt + (size_t)((u).pn >> 2) * (1024 * 512 * 2) + (size_t)((u).pn & 3) * tstepB : (const char*)g.Bt + (size_t)(u).pn * tstepB)
#define PG8_NT(u) (YB ? ((((u).pn >> 2) == 3) ? 8 : 4) : g.K / BK)
    const char* cA = PG8_APTR(cur); const char* cB = PG8_BPTR(cur); nt = PG8_NT(cur);
    S.a_ready(cur);
    if constexpr (SP2) {
        PG8_STAGE(PG8_SB(0, 0), cB, voffB); PG8_STAGE(PG8_SB(0, 1), cB + hstepB, voffB); PG8_STAGE(PG8_SA(0, 0), cA, voffA); PG8_STAGE(PG8_SA(0, 1), cA + hstepA, voffA);
        if (wr == 1) PG8_BAR;
        PG8_WAIT_V(2); PG8_BAR;
        PG8_STAGE(PG8_SB(1, 0), cB + kstep, voffB); PG8_STAGE(PG8_SA(1, 0), cA + kstep, voffA); PG8_STAGE(PG8_SB(1, 1), cB + hstepB + kstep, voffB);
        PG8_WAIT_V(6); PG8_BAR;
    } else {
        PG8_STAGE(PG8_SB(0, 0), cB, voffB); PG8_STAGE(PG8_SA(0, 0), cA, voffA); PG8_STAGE(PG8_SB(0, 1), cB + hstepB, voffB); PG8_STAGE(PG8_SA(0, 1), cA + hstepA, voffA);
        if (wr == 1) PG8_BAR;
        PG8_WAIT_V(4); PG8_BAR;
        PG8_STAGE(PG8_SB(1, 0), cB + kstep, voffB); PG8_STAGE(PG8_SA(1, 0), cA + kstep, voffA); PG8_STAGE(PG8_SB(1, 1), cB + hstepB + kstep, voffB);
        PG8_WAIT_V(6); PG8_BAR;
    }
    for (;;) {
        const bool has_next = S.next(ui + 1, nxt);
        const char* nA = has_next ? PG8_APTR(nxt) : cA; const char* nB = has_next ? PG8_BPTR(nxt) : cB;
        for (int t = 0; t < nt; t += 2) {
            const bool last = (t == nt - 2);
            const char* a1 = cA + (size_t)(t + 1) * kstep;
            const char* a2 = last ? nA : cA + (size_t)(t + 2) * kstep; const char* b2 = last ? nB : cB + (size_t)(t + 2) * kstep;
            const char* a3 = a2 + kstep; const char* b3 = b2 + kstep;
            if (last && has_next) S.a_ready(nxt);
            if constexpr (SP2) {
            PG8_LDB(B0, 0, 0); PG8_LDB(B1, 0, 1); PG8_SCHED; PG8_LDA(At, 0, 0); PG8_STAGE(PG8_SA(1, 1), a1 + hstepA, voffA);
            PG8_WAIT_V(8); PG8_WAIT_L(0); PG8_BAR; PG8_MMA(0, 0, At, B0); PG8_MMA(0, 1, At, B1); PG8_BAR; PG8_SCHED;
            PG8_LDA(At, 0, 1); PG8_STAGE(PG8_SB(0, 0), b2, voffB); PG8_STAGE(PG8_SB(0, 1), b2 + hstepB, voffB); PG8_STAGE(PG8_SA(0, 0), a2, voffA);
            PG8_WAIT_V(8); PG8_WAIT_L(0); PG8_BAR; PG8_MMA(1, 0, At, B0); PG8_MMA(1, 1, At, B1); PG8_BAR; PG8_SCHED;
            PG8_LDB(B0, 1, 0); PG8_LDB(B1, 1, 1); PG8_SCHED; PG8_LDA(At, 1, 0); PG8_STAGE(PG8_SA(0, 1), a2 + hstepA, voffA);
            PG8_WAIT_V(8); PG8_WAIT_L(0); PG8_BAR; PG8_MMA(0, 0, At, B0); PG8_MMA(0, 1, At, B1); PG8_BAR; PG8_SCHED;
            PG8_LDA(At, 1, 1); PG8_STAGE(PG8_SB(1, 0), b3, voffB); PG8_STAGE(PG8_SB(1, 1), b3 + hstepB, voffB); PG8_STAGE(PG8_SA(1, 0), a3, voffA);
            PG8_WAIT_V(8); PG8_WAIT_L(0); PG8_BAR; PG8_MMA(1, 0, At, B0); PG8_MMA(1, 1, At, B1); PG8_BAR; PG8_SCHED;
            } else {
            PG8_LDB(B0, 0, 0); PG8_SCHED; PG8_LDA(At, 0, 0); PG8_STAGE(PG8_SA(1, 1), a1 + hstepA, voffA);
            PG8_WAIT_L(8); PG8_BAR; PG8_WAIT_L(0); PG8_MMA(0, 0, At, B0); PG8_BAR; PG8_SCHED;
            PG8_LDB(B1, 0, 1); PG8_STAGE(PG8_SB(0, 0), b2, voffB);
            PG8_BAR; PG8_WAIT_L(0); PG8_MMA(0, 1, At, B1); PG8_BAR;
            PG8_LDA(At, 0, 1); PG8_STAGE(PG8_SA(0, 0), a2, voffA);
            PG8_BAR; PG8_WAIT_L(0); PG8_MMA(1, 0, At, B0); PG8_BAR; PG8_SCHED;
            PG8_STAGE(PG8_SB(0, 1), b2 + hstepB, voffB);
            PG8_WAIT_V(6); PG8_BAR; PG8_MMA(1, 1, At, B1); PG8_BAR;
            PG8_LDB(B0, 1, 0); PG8_SCHED; PG8_LDA(At, 1, 0); PG8_STAGE(PG8_SA(0, 1), a2 + hstepA, voffA);
            PG8_WAIT_L(8); PG8_BAR; PG8_WAIT_L(0); PG8_MMA(0, 0, At, B0); PG8_BAR; PG8_SCHED;
            PG8_LDB(B1, 1, 1); PG8_STAGE(PG8_SB(1, 0), b3, voffB);
            PG8_BAR; PG8_WAIT_L(0); PG8_MMA(0, 1, At, B1); PG8_BAR;
            PG8_LDA(At, 1, 1); PG8_STAGE(PG8_SA(1, 0), a3, voffA);
            PG8_BAR; PG8_WAIT_L(0); PG8_MMA(1, 0, At, B0); PG8_BAR; PG8_SCHED;
            PG8_STAGE(PG8_SB(1, 1), b3 + hstepB, voffB);
            PG8_WAIT_V(6); PG8_BAR; PG8_MMA(1, 1, At, B1); PG8_BAR;
            }
        }
        if constexpr (ALIGN_EPI) { if (wr == 0) PG8_BAR; }
        if constexpr (!Epi::AFTER_DRAIN) { E(acc, cur, wr, wc, fr, fq); S.done(cur); }
        if (!has_next) break;
#pragma unroll
        for (int a = 0; a < 2; ++a)
#pragma unroll
            for (int b = 0; b < 2; ++b)
#pragma unroll
                for (int m = 0; m < 4; ++m)
#pragma unroll
                    for (int n = 0; n < 2; ++n) acc[a][b][m][n] = (f32x4){0.f, 0.f, 0.f, 0.f};
        cur = nxt; cA = nA; cB = nB; ++ui; nt = PG8_NT(cur);
        if constexpr (ALIGN_EPI) { if (wr == 1) PG8_BAR; }
    }
    PG8_WAIT_V(0);
    if constexpr (!ALIGN_EPI) { if (wr == 0) PG8_BAR; }
    PG8_BAR;
    if constexpr (Epi::AFTER_DRAIN) { E.fused(acc, cur, wr, wc, fr, fq, lds, wid, lane); S.done(cur); }
#undef PG8_APTR
#undef PG8_BPTR
#undef PG8_NT
#undef PG8_SA
#undef PG8_SB
#undef PG8_STAGE
#undef PG8_LDA
#undef PG8_LDB
#undef PG8_MMA
#undef PG8_WAIT_V
#undef PG8_WAIT_L
#undef PG8_BAR
#undef PG8_SCHED
}

struct FusedOrder {
    int G, c;
    __device__ __forceinline__ bool next(int i, Unit& u) const {
        const int pair = c + (i >> 3) * G; if (pair >= 256) return false;
        const int k = i & 7, x = pair & 7, j = pair >> 3, q = j >> 3;
        u.pm = x * 8 + (j & 7); u.pn = (k < 4) ? 4 * k + q : 16 + 4 * q + (k - 4); return true;
    }
    __device__ __forceinline__ void a_ready(const Unit&) const {}
    __device__ __forceinline__ void done(const Unit&) const {}
};
struct TailOrder {
    int half, c;
    __device__ __forceinline__ bool next(int i, Unit& u) const { const int idx = c + i * half; if (c >= half || idx >= 128) return false; u.pm = idx >> 1; u.pn = 16 + (idx & 1); return true; }
    __device__ __forceinline__ void a_ready(const Unit&) const {}
    __device__ __forceinline__ void done(const Unit&) const {}
};
template <class Sched, class EpiYT, class EpiGT>
__device__ __forceinline__ void gemm_phase_fused(const int tid, PG8_LAS unsigned char* lds, const bf16_t* Pm, const bf16_t* Hm, const bf16_t* Wm, const bf16_t* Wg, const Sched& S, const EpiYT& EY, const EpiGT& EG) {
    constexpr bool ALIGN_EPI = true, SP2 = true;
    const int wid = __builtin_amdgcn_readfirstlane(tid >> 6), lane = tid & 63, wr = wid >> 2, wc = wid & 3, fr = lane & 15, fq = lane >> 4;
    int nt;
    unsigned vAy[2], vAg[2], vBy[2], vBg[2];
#pragma unroll
    for (int i = 0; i < 2; ++i) { int R, C; stage_rc(tid * 16 + i * 8192, R, C); const int Rp = (R & ~31) + perm32(R & 31);
        vAy[i] = (unsigned)(R * ::NP + C) * 2u; vAg[i] = (unsigned)(R * 1024 + C) * 2u; vBy[i] = (unsigned)(Rp * 512 + C) * 2u; vBg[i] = (unsigned)(R * 1024 + C) * 2u; }
    const size_t kstep = (size_t)(BK * 2);
    const size_t hsAy = (size_t)HALF * ::NP * 2, hsAg = (size_t)HALF * 1024 * 2, hsBy = (size_t)HALF * 512 * 2, hsBg = (size_t)HALF * 1024 * 2;
    const unsigned ldsw = (unsigned)wid * 1024u;
    const int aoff = lds_byte(wr * 64 + fr, fq * 8), boff = lds_byte(wc * 32 + fr, fq * 8);
#define PG8_SA(b, h) (((b) * 2 + (h)) * HTB)
#define PG8_SB(b, h) ((4 + (b) * 2 + (h)) * HTB)
#define PG8_STAGE(bufoff, gbase, voff) do { _Pragma("unroll") for (int _i = 0; _i < 2; ++_i) \
        __builtin_amdgcn_global_load_lds((const unsigned*)((const char*)(gbase) + (voff)[_i]), (PG8_LAS unsigned*)(lds + (bufoff) + ldsw + _i * 8192), 16, 0, 0); } while (0)
#define PG8_LDA(dst, b, h) do { _Pragma("unroll") for (int m = 0; m < 4; ++m) _Pragma("unroll") for (int k = 0; k < 2; ++k) dst[m][k] = *(const PG8_LAS bf16x8*)(lds + PG8_SA(b, h) + aoff + m * 2048 + k * 1024); } while (0)
#define PG8_LDB(dst, b, h) do { _Pragma("unroll") for (int n = 0; n < 2; ++n) _Pragma("unroll") for (int k = 0; k < 2; ++k) dst[n][k] = *(const PG8_LAS bf16x8*)(lds + PG8_SB(b, h) + boff + n * 2048 + k * 1024); } while (0)
#define PG8_MMA(ai, bj, At, Bt) do { __builtin_amdgcn_s_setprio(1); _Pragma("unroll") for (int m = 0; m < 4; ++m) _Pragma("unroll") for (int n = 0; n < 2; ++n) _Pragma("unroll") for (int k = 0; k < 2; ++k) \
        acc[ai][bj][m][n] = __builtin_amdgcn_mfma_f32_16x16x32_bf16(Bt[n][k], At[m][k], acc[ai][bj][m][n], 0, 0, 0); __builtin_amdgcn_s_setprio(0); } while (0)
#define PG8_WAIT_V(n) asm volatile("s_waitcnt vmcnt(" #n ")" ::: "memory")
#define PG8_WAIT_L(n) asm volatile("s_waitcnt lgkmcnt(" #n ")" ::: "memory")
#define PG8_BAR __builtin_amdgcn_s_barrier()
#define PG8_SCHED __builtin_amdgcn_sched_barrier(0)
    Unit cur, nxt; int ui = 0;
    if (!S.next(0, cur)) return;
    f32x4 acc[2][2][4][2];
#pragma unroll
    for (int a = 0; a < 2; ++a)
#pragma unroll
        for (int b = 0; b < 2; ++b)
#pragma unroll
            for (int m = 0; m < 4; ++m)
#pragma unroll
                for (int n = 0; n < 2; ++n) acc[a][b][m][n] = (f32x4){0.f, 0.f, 0.f, 0.f};
    bf16x8 At[4][2], B0[2][2], B1[2][2];
#define PGF_ISY(u) ((u).pn < 16)
#define PG8_APTR(u) (PGF_ISY(u) ? (const char*)Pm + (size_t)(u).pm * (2 * hsAy) + 2 * (((u).pn >> 2) == 0 ? 256 : ((u).pn >> 2) == 1 ? 1280 : ((u).pn >> 2) == 2 ? 2304 : 4096) : (const char*)Hm + (size_t)(u).pm * (2 * hsAg))
#define PG8_BPTR(u) (PGF_ISY(u) ? (const char*)Wm + (size_t)((u).pn >> 2) * (1024 * 512 * 2) + (size_t)((u).pn & 3) * (2 * hsBy) : (const char*)Wg + (size_t)((u).pn - 16) * (2 * hsBg))
#define PG8_NT(u) (PGF_ISY(u) ? ((((u).pn >> 2) == 3) ? 8 : 4) : 16)
#define PGF_SEL(dst, c, y, g_) do { dst[0] = (c) ? y[0] : g_[0]; dst[1] = (c) ? y[1] : g_[1]; } while (0)
    const char* cA = PG8_APTR(cur); const char* cB = PG8_BPTR(cur); nt = PG8_NT(cur);
    bool cy = PGF_ISY(cur);
    unsigned vAc[2], vBc[2]; PGF_SEL(vAc, cy, vAy, vAg); PGF_SEL(vBc, cy, vBy, vBg);
    size_t hsAc = cy ? hsAy : hsAg, hsBc = cy ? hsBy : hsBg;
    S.a_ready(cur);
    if constexpr (SP2) {
        PG8_STAGE(PG8_SB(0, 0), cB, vBc); PG8_STAGE(PG8_SB(0, 1), cB + hsBc, vBc); PG8_STAGE(PG8_SA(0, 0), cA, vAc); PG8_STAGE(PG8_SA(0, 1), cA + hsAc, vAc);
        if (wr == 1) PG8_BAR;
        PG8_WAIT_V(2); PG8_BAR;
        PG8_STAGE(PG8_SB(1, 0), cB + kstep, vBc); PG8_STAGE(PG8_SA(1, 0), cA + kstep, vAc); PG8_STAGE(PG8_SB(1, 1), cB + hsBc + kstep, vBc);
        PG8_WAIT_V(6); PG8_BAR;
    } else {
        PG8_STAGE(PG8_SB(0, 0), cB, vBc); PG8_STAGE(PG8_SA(0, 0), cA, vAc); PG8_STAGE(PG8_SB(0, 1), cB + hsBc, vBc); PG8_STAGE(PG8_SA(0, 1), cA + hsAc, vAc);
        if (wr == 1) PG8_BAR;
        PG8_WAIT_V(4); PG8_BAR;
        PG8_STAGE(PG8_SB(1, 0), cB + kstep, vBc); PG8_STAGE(PG8_SA(1, 0), cA + kstep, vAc); PG8_STAGE(PG8_SB(1, 1), cB + hsBc + kstep, vBc);
        PG8_WAIT_V(6); PG8_BAR;
    }
    for (;;) {
        const bool has_next = S.next(ui + 1, nxt); const bool ny = has_next ? PGF_ISY(nxt) : cy;
        const char* nA = has_next ? PG8_APTR(nxt) : cA; const char* nB = has_next ? PG8_BPTR(nxt) : cB;
        for (int t = 0; t < nt; t += 2) {
            const bool last = (t == nt - 2); const bool sy = last ? ny : cy;
            unsigned vAn[2], vBn[2]; PGF_SEL(vAn, sy, vAy, vAg); PGF_SEL(vBn, sy, vBy, vBg); const size_t hsAn = sy ? hsAy : hsAg, hsBn = sy ? hsBy : hsBg;
            const char* a1 = cA + (size_t)(t + 1) * kstep;
            const char* a2 = last ? nA : cA + (size_t)(t + 2) * kstep; const char* b2 = last ? nB : cB + (size_t)(t + 2) * kstep;
            const char* a3 = a2 + kstep; const char* b3 = b2 + kstep;
            if (last && has_next) S.a_ready(nxt);
            if constexpr (SP2) {
            PG8_LDB(B0, 0, 0); PG8_LDB(B1, 0, 1); PG8_SCHED; PG8_LDA(At, 0, 0); PG8_STAGE(PG8_SA(1, 1), a1 + hsAc, vAc);
            PG8_WAIT_V(8); PG8_WAIT_L(0); PG8_BAR; PG8_MMA(0, 0, At, B0); PG8_MMA(0, 1, At, B1); PG8_BAR; PG8_SCHED;
            PG8_LDA(At, 0, 1); PG8_STAGE(PG8_SB(0, 0), b2, vBn); PG8_STAGE(PG8_SB(0, 1), b2 + hsBn, vBn); PG8_STAGE(PG8_SA(0, 0), a2, vAn);
            PG8_WAIT_V(8); PG8_WAIT_L(0); PG8_BAR; PG8_MMA(1, 0, At, B0); PG8_MMA(1, 1, At, B1); PG8_BAR; PG8_SCHED;
            PG8_LDB(B0, 1, 0); PG8_LDB(B1, 1, 1); PG8_SCHED; PG8_LDA(At, 1, 0); PG8_STAGE(PG8_SA(0, 1), a2 + hsAn, vAn);
            PG8_WAIT_V(8); PG8_WAIT_L(0); PG8_BAR; PG8_MMA(0, 0, At, B0); PG8_MMA(0, 1, At, B1); PG8_BAR; PG8_SCHED;
            PG8_LDA(At, 1, 1); PG8_STAGE(PG8_SB(1, 0), b3, vBn); PG8_STAGE(PG8_SB(1, 1), b3 + hsBn, vBn); PG8_STAGE(PG8_SA(1, 0), a3, vAn);
            PG8_WAIT_V(8); PG8_WAIT_L(0); PG8_BAR; PG8_MMA(1, 0, At, B0); PG8_MMA(1, 1, At, B1); PG8_BAR; PG8_SCHED;
            } else {
            PG8_LDB(B0, 0, 0); PG8_SCHED; PG8_LDA(At, 0, 0); PG8_STAGE(PG8_SA(1, 1), a1 + hsAc, vAc);
            PG8_WAIT_L(8); PG8_BAR; PG8_WAIT_L(0); PG8_MMA(0, 0, At, B0); PG8_BAR; PG8_SCHED;
            PG8_LDB(B1, 0, 1); PG8_STAGE(PG8_SB(0, 0), b2, vBn);
            PG8_BAR; PG8_WAIT_L(0); PG8_MMA(0, 1, At, B1); PG8_BAR;
            PG8_LDA(At, 0, 1); PG8_STAGE(PG8_SA(0, 0), a2, vAn);
            PG8_BAR; PG8_WAIT_L(0); PG8_MMA(1, 0, At, B0); PG8_BAR; PG8_SCHED;
            PG8_STAGE(PG8_SB(0, 1), b2 + hsBn, vBn);
            PG8_WAIT_V(6); PG8_BAR; PG8_MMA(1, 1, At, B1); PG8_BAR;
            PG8_LDB(B0, 1, 0); PG8_SCHED; PG8_LDA(At, 1, 0); PG8_STAGE(PG8_SA(0, 1), a2 + hsAn, vAn);
            PG8_WAIT_L(8); PG8_BAR; PG8_WAIT_L(0); PG8_MMA(0, 0, At, B0); PG8_BAR; PG8_SCHED;
            PG8_LDB(B1, 1, 1); PG8_STAGE(PG8_SB(1, 0), b3, vBn);
            PG8_BAR; PG8_WAIT_L(0); PG8_MMA(0, 1, At, B1); PG8_BAR;
            PG8_LDA(At, 1, 1); PG8_STAGE(PG8_SA(1, 0), a3, vAn);
            PG8_BAR; PG8_WAIT_L(0); PG8_MMA(1, 0, At, B0); PG8_BAR; PG8_SCHED;
            PG8_STAGE(PG8_SB(1, 1), b3 + hsBn, vBn);
            PG8_WAIT_V(6); PG8_BAR; PG8_MMA(1, 1, At, B1); PG8_BAR;
            }
        }
        if constexpr (ALIGN_EPI) { if (wr == 0) PG8_BAR; }
        if (cy) EY(acc, cur, wr, wc, fr, fq); else { const Unit ug{cur.pm, cur.pn - 16}; EG(acc, ug, wr, wc, fr, fq); }
        if (!has_next) break;
#pragma unroll
        for (int a = 0; a < 2; ++a)
#pragma unroll
            for (int b = 0; b < 2; ++b)
#pragma unroll
                for (int m = 0; m < 4; ++m)
#pragma unroll
                    for (int n = 0; n < 2; ++n) acc[a][b][m][n] = (f32x4){0.f, 0.f, 0.f, 0.f};
        cur = nxt; cA = nA; cB = nB; ++ui; nt = PG8_NT(cur); cy = ny; PGF_SEL(vAc, cy, vAy, vAg); PGF_SEL(vBc, cy, vBy, vBg); hsAc = cy ? hsAy : hsAg; hsBc = cy ? hsBy : hsBg;
        if constexpr (ALIGN_EPI) { if (wr == 1) PG8_BAR; }
    }
    PG8_WAIT_V(0);
    if constexpr (!ALIGN_EPI) { if (wr == 0) PG8_BAR; }
    PG8_BAR;
#undef PGF_ISY
#undef PGF_SEL
#undef PG8_APTR
#undef PG8_BPTR
#undef PG8_NT
#undef PG8_SA
#undef PG8_SB
#undef PG8_STAGE
#undef PG8_LDA
#undef PG8_LDB
#undef PG8_MMA
#undef PG8_WAIT_V
#undef PG8_WAIT_L
#undef PG8_BAR
#undef PG8_SCHED
}
}


namespace attn_body {
using bf16=__hip_bfloat16;
using bf16x8=__attribute__((ext_vector_type(8)))short;
using s16x4=__attribute__((ext_vector_type(4)))short;
using f32x16=__attribute__((ext_vector_type(16)))float;
using u32x4=__attribute__((ext_vector_type(4)))unsigned;
constexpr int SEQ=4096,D=64,PQ=4608,PO=1024;
constexpr int NW=8,QBLK=32,QB=QBLK*NW,KVBLK=64;
__device__ __forceinline__ int crow(int r,int hi){return (r&3)+8*(r>>2)+4*hi;}
#define SBAR() __builtin_amdgcn_sched_barrier(0)
__device__ __forceinline__ void cmask(f32x16&p0,f32x16&p1,int jb,int qrel,int hi){
  const float NEG=-INFINITY; int kb=64*jb+4*hi;
  #pragma unroll
  for(int r=0;r<16;++r){int kv=kb+(r&3)+8*(r>>2); if(kv>qrel)p0[r]=NEG; if(kv+32>qrel)p1[r]=NEG;}
}
constexpr int NSLOT=3, SLOTB=8192;
constexpr int LDS_K=0, LDS_V=NSLOT*SLOTB, LDS_WS=2*NSLOT*SLOTB, LDS_OST=LDS_WS+NW*64*4, LDS_BYTES=LDS_OST+NW*4096;
constexpr float C2=0.125f*1.4426950408889634f;
__device__ __forceinline__ void glds16(const void*sbase,unsigned voff,unsigned lds_dst){unsigned keep;
  asm volatile("s_mov_b32 %0, m0\n\ts_mov_b32 m0, %3\n\ts_nop 0\n\tglobal_load_lds_dwordx4 %1, %2\n\ts_mov_b32 m0, %0":"=&s"(keep):"v"(voff),"s"(sbase),"s"(lds_dst):"memory");}
__device__ __forceinline__ float max3f(float a,float b,float c){float r;asm("v_max3_f32 %0, %1, %2, %3":"=v"(r):"v"(a),"v"(b),"v"(c));return r;}
__device__ __forceinline__ float max2f(float a,float b){float r;asm("v_max_f32_e32 %0, %1, %2":"=v"(r):"v"(a),"v"(b));return r;}
__device__ __forceinline__ float fadd_s(float a,float b){float r;asm("v_add_f32_e32 %0, %1, %2":"=v"(r):"v"(a),"v"(b));return r;}
__device__ __forceinline__ float fsub_s(float a,float b){float r;asm("v_sub_f32_e32 %0, %1, %2":"=v"(r):"v"(a),"v"(b));return r;}
typedef float f32x2_t __attribute__((ext_vector_type(2))); typedef __bf16 bf16x2_t __attribute__((ext_vector_type(2)));
__device__ __forceinline__ unsigned cvtpk_s(float lo,float hi){f32x2_t v={lo,hi};bf16x2_t b=__builtin_convertvector(v,bf16x2_t);return __builtin_bit_cast(unsigned,b);}
#define WAIT_BAR(N) asm volatile("s_waitcnt vmcnt(" #N ") lgkmcnt(0)\n\ts_barrier":::"memory")
__device__ __forceinline__ void qkt(f32x16&p0,f32x16&p1,const char*Kslot,const bf16x8*qr,const f32x16&negm,int r32,int hi){
  const char*kb=Kslot+hi*1024+r32*16;
  #pragma unroll
  for(int d0=0;d0<4;++d0){
    const bf16x8 b0=*reinterpret_cast<const bf16x8*>(kb+d0*2048);
    const bf16x8 b1=*reinterpret_cast<const bf16x8*>(kb+d0*2048+512);
    if(d0==0){p0=__builtin_amdgcn_mfma_f32_32x32x16_bf16(b0,qr[0],negm,0,0,0);p1=__builtin_amdgcn_mfma_f32_32x32x16_bf16(b1,qr[0],negm,0,0,0);}
    else{p0=__builtin_amdgcn_mfma_f32_32x32x16_bf16(b0,qr[d0],p0,0,0,0);p1=__builtin_amdgcn_mfma_f32_32x32x16_bf16(b1,qr[d0],p1,0,0,0);}}
}
typedef __attribute__((address_space(3))) const char* lds_cptr;
typedef short v4i16_t __attribute__((ext_vector_type(4)));
__device__ __forceinline__ void kload8(bf16x8*kf,lds_cptr kp){
  kf[0]=*(const __attribute__((address_space(3))) bf16x8*)(kp);      kf[1]=*(const __attribute__((address_space(3))) bf16x8*)(kp+512);
  kf[2]=*(const __attribute__((address_space(3))) bf16x8*)(kp+2048); kf[3]=*(const __attribute__((address_space(3))) bf16x8*)(kp+2560);
  kf[4]=*(const __attribute__((address_space(3))) bf16x8*)(kp+4096); kf[5]=*(const __attribute__((address_space(3))) bf16x8*)(kp+4608);
  kf[6]=*(const __attribute__((address_space(3))) bf16x8*)(kp+6144); kf[7]=*(const __attribute__((address_space(3))) bf16x8*)(kp+6656);
}
__device__ __forceinline__ void kload2(bf16x8*kf,lds_cptr kp,int j){ kf[2*j]=*(const __attribute__((address_space(3))) bf16x8*)(kp+j*2048); kf[2*j+1]=*(const __attribute__((address_space(3))) bf16x8*)(kp+j*2048+512); }
__device__ __forceinline__ s16x4 vtr(lds_cptr p){ return __builtin_bit_cast(s16x4,__builtin_amdgcn_ds_read_tr16_b64_v4i16((__attribute__((address_space(3))) v4i16_t*)p)); }
__device__ __forceinline__ float rowmax(const f32x16&p0,const f32x16&p1){
  float a=max3f(p0[0],p0[1],p1[0]),b=max3f(p0[2],p0[3],p1[1]);a=max3f(a,p1[2],p1[3]);
  #pragma unroll
  for(int r=4;r<16;r+=4){a=max3f(a,p0[r],p0[r+1]);b=max3f(b,p0[r+2],p0[r+3]);a=max3f(a,p1[r],p1[r+1]);b=max3f(b,p1[r+2],p1[r+3]);}
  const float m=max2f(a,b);
  auto rr=__builtin_amdgcn_permlane32_swap(__float_as_uint(m),__float_as_uint(m),false,false);
  return max2f(__uint_as_float(rr[0]),__uint_as_float(rr[1]));
}
__device__ __forceinline__ void pv(f32x16*o,int vb,bf16x8 pa0,bf16x8 pa1,bf16x8 pa2,bf16x8 pa3){
  #pragma unroll
  for(int d0=0;d0<2;++d0){s16x4 lo[4],hi[4];
    #pragma unroll
    for(int ks=0;ks<4;++ks){
      asm volatile("ds_read_b64_tr_b16 %0,%1 offset:%c2":"=&v"(lo[ks]):"v"(vb),"i"(d0*4096+ks*1024):"memory");
      asm volatile("ds_read_b64_tr_b16 %0,%1 offset:%c2":"=&v"(hi[ks]):"v"(vb),"i"(d0*4096+ks*1024+512):"memory");}
    asm volatile("s_waitcnt lgkmcnt(0)":::"memory");SBAR();
    #define PK(k) (bf16x8){lo[k][0],lo[k][1],lo[k][2],lo[k][3],hi[k][0],hi[k][1],hi[k][2],hi[k][3]}
    o[d0]=__builtin_amdgcn_mfma_f32_32x32x16_bf16(pa0,PK(0),o[d0],0,0,0);
    o[d0]=__builtin_amdgcn_mfma_f32_32x32x16_bf16(pa1,PK(1),o[d0],0,0,0);
    o[d0]=__builtin_amdgcn_mfma_f32_32x32x16_bf16(pa2,PK(2),o[d0],0,0,0);
    o[d0]=__builtin_amdgcn_mfma_f32_32x32x16_bf16(pa3,PK(3),o[d0],0,0,0);
    #undef PK
  }
}
#define ATTN_STORE16(p,v) (*(u32x4*)(p)=(v))
template<int THRL> __device__ __forceinline__ void attn_unit(int tid,int b,int qb,const bf16*Q,const bf16*__restrict__ K,const bf16*__restrict__ V,bf16*O,char*shm){
  const int lane=tid&63,r32=lane&31,hi=lane>>5; const int wid=__builtin_amdgcn_readfirstlane(tid>>6);
  const long rowbase=(long)b*SEQ; const int q0=qb*QB;
  const bf16*Qw=Q+(rowbase+q0+wid*QBLK)*PQ;
  const bf16*Kh=K+rowbase*PQ,*Vh=V+rowbase*PQ;
  const unsigned lds0=(unsigned)(uintptr_t)shm;
  float*wsf=(float*)(shm+LDS_WS)+wid*64;
  const unsigned kvoff=(unsigned)((lane*PQ+wid*8)*2);
  const unsigned vvoff=(unsigned)(((16*(wid&3)+(lane>>2))*PQ+(wid>>2)*32+(lane&3)*8)*2);
  const unsigned kdst=lds0+LDS_K+wid*1024, vdst=lds0+LDS_V+wid*1024;
  #define DMA_K(t,slot) glds16(Kh+(long)(t)*KVBLK*PQ,kvoff,(unsigned)__builtin_amdgcn_readfirstlane(kdst+(slot)))
  #define DMA_V(t,slot) glds16(Vh+(long)(t)*KVBLK*PQ,vvoff,(unsigned)__builtin_amdgcn_readfirstlane(vdst+(slot)))
  const int vb0=(int)(lds0+LDS_V)+((lane>>4)&1)*32+(lane&3)*8+(4*hi+((lane&15)>>2))*64;
  const char*Kbase=shm+LDS_K; bf16x8 kf[8];
  const lds_cptr shm3=(lds_cptr)shm; const lds_cptr kp0=shm3+LDS_K+hi*1024+r32*16; const lds_cptr vp0=shm3+LDS_V+((lane>>4)&1)*32+(lane&3)*8+(4*hi+((lane&15)>>2))*64;
  const int NT=(q0+QB)/KVBLK;
  DMA_K(0,0);DMA_V(0,0);DMA_K(1,SLOTB);
  bf16x8 qr[4];
  #pragma unroll
  for(int d0=0;d0<4;++d0)qr[d0]=*reinterpret_cast<const bf16x8*>(&Qw[(long)r32*PQ+d0*16+hi*8]);
  float mhat=0.f,l_reg=0.f;f32x16 o[2];o[0]=f32x16{};o[1]=f32x16{};f32x16 negm=f32x16{};asm volatile("":"+v"(negm));
  const int qrel=wid*QBLK+r32;
  #define CMASK(P0,P1,t) do{int jb_=(t)-(NT-4); if(jb_>=0)cmask(P0,P1,jb_,qrel,hi);}while(0)
  bool resc=false;
  #define START(P0,P1) do{ const float rm=rowmax(P0,P1); resc=false; \
    { const float dl=rm; mhat=fadd_s(mhat,dl); \
      _Pragma("unroll") for(int r=0;r<16;++r){P0[r]=fsub_s(P0[r],dl);P1[r]=fsub_s(P1[r],dl);} \
      _Pragma("unroll") for(int r=0;r<16;++r)negm[r]=-mhat; asm volatile("":"+v"(negm)); } \
    _Pragma("unroll") for(int r=0;r<16;++r)P0[r]=__builtin_amdgcn_exp2f(P0[r]); }while(0)
  #define RESC() do{ if(resc){ asm volatile("s_waitcnt lgkmcnt(0)":::"memory"); \
      _Pragma("unroll") for(int d_=0;d_<2;++d_) _Pragma("unroll") for(int r=0;r<16;++r)o[d_][r]*=wsf[crow(r,hi)]; } }while(0)
  f32x16 pA0,pA1,pB0,pB1;
  int sl_prev=0,sl_cur=0,sl_next=SLOTB;
  #define ROT() do{sl_prev=sl_cur;sl_cur=sl_next;sl_next=(sl_next==(NSLOT-1)*SLOTB)?0:sl_next+SLOTB;}while(0)
  DMA_K(2,2*SLOTB);
  WAIT_BAR(3);
  qkt(pA0,pA1,Kbase,qr,negm,r32,hi);asm volatile("s_nop 15\n\ts_nop 7":"+v"(pA0),"+v"(pA1));CMASK(pA0,pA1,0);
  START(pA0,pA1);
  _Pragma("unroll") for(int r=0;r<16;++r)pA1[r]=__builtin_amdgcn_exp2f(pA1[r]);
  WAIT_BAR(0);
  DMA_K(3,0);DMA_V(1,SLOTB);
  ROT();
  kload8(kf,kp0+sl_cur);
  WAIT_BAR(2);
  s16x4 vlo[8],vhi[8]; u32x4 pw0,pw1,pw2,pw3;
  #define PKW(P,B) cvtpk_s(P[B],P[B+1])
  #define PAF(k) __builtin_bit_cast(bf16x8,pw##k)
  #define VFR(i) (bf16x8){vlo[i][0],vlo[i][1],vlo[i][2],vlo[i][3],vhi[i][0],vhi[i][1],vhi[i][2],vhi[i][3]}
  #define PIN(x) asm volatile("":"+v"(x))
  #define MX3(a,b,c) __builtin_fmaxf(__builtin_fmaxf((a),(b)),(c))
  #define GAPA(MF,A0,A1,A2,A3,W0,W1,PW) do{ MF; sacc+=A0; sacc+=A1; sacc+=A2; sacc+=A3; PIN(sacc); W0; W1; PIN(PW); SBAR(); }while(0)
  #define EX(v) __builtin_amdgcn_exp2f(v)
  #define GAPB(MF,X,B) do{ MF; X[B]=EX(X[B]); X[B+1]=EX(X[B+1]); X[B+2]=EX(X[B+2]); X[B+3]=EX(X[B+3]); PIN(X); SBAR(); }while(0)
  #define VRD(i) do{ vlo[i]=vtr(vp_+(((i)>>2)*4096+((i)&3)*1024)); vhi[i]=vtr(vp_+(((i)>>2)*4096+((i)&3)*1024+512)); }while(0)
  #define KRD(G,j) do{ if(G){ kload2(kf,kp0+sl_next,j); SBAR(); } }while(0)
  #define STEP(C0,C1,P0,P1,t,GK,GV,GL) do{ SBAR(); \
    const lds_cptr vp_=vp0+sl_prev; \
    VRD(0); SBAR(); float sacc=(P0[0]+P0[1]); \
    GAPA(C0=__builtin_amdgcn_mfma_f32_32x32x16_bf16(kf[0],qr[0],negm,0,0,0), P0[2],P0[3],P0[4],P0[5],     pw0[0]=PKW(P0,0), pw0[1]=PKW(P0,2), pw0); \
    VRD(4); SBAR(); GAPA(C1=__builtin_amdgcn_mfma_f32_32x32x16_bf16(kf[1],qr[0],negm,0,0,0), P0[6],P0[7],P0[8],P0[9],     pw0[2]=PKW(P0,4), pw0[3]=PKW(P0,6), pw0); \
    VRD(1); SBAR(); GAPA(C0=__builtin_amdgcn_mfma_f32_32x32x16_bf16(kf[2],qr[1],C0,0,0,0),   P0[10],P0[11],P0[12],P0[13], pw1[0]=PKW(P0,8), pw1[1]=PKW(P0,10), pw1); \
    VRD(5); SBAR(); GAPA(C1=__builtin_amdgcn_mfma_f32_32x32x16_bf16(kf[3],qr[1],C1,0,0,0),   P0[14],P0[15],P1[0],P1[1],   pw1[2]=PKW(P0,12),pw1[3]=PKW(P0,14), pw1); \
    VRD(2); SBAR(); GAPA(C0=__builtin_amdgcn_mfma_f32_32x32x16_bf16(kf[4],qr[2],C0,0,0,0),   P1[2],P1[3],P1[4],P1[5],     pw2[0]=PKW(P1,0), pw2[1]=PKW(P1,2), pw2); \
    VRD(6); SBAR(); GAPA(C1=__builtin_amdgcn_mfma_f32_32x32x16_bf16(kf[5],qr[2],C1,0,0,0),   P1[6],P1[7],P1[8],P1[9],     pw2[2]=PKW(P1,4), pw2[3]=PKW(P1,6), pw2); \
    VRD(3); SBAR(); GAPA(C0=__builtin_amdgcn_mfma_f32_32x32x16_bf16(kf[6],qr[3],C0,0,0,0),   P1[10],P1[11],P1[12],P1[13], pw3[0]=PKW(P1,8), pw3[1]=PKW(P1,10), pw3); \
    VRD(7); SBAR(); GAPA(C1=__builtin_amdgcn_mfma_f32_32x32x16_bf16(kf[7],qr[3],C1,0,0,0),   P1[14],P1[15],0.f,0.f,       pw3[2]=PKW(P1,12),pw3[3]=PKW(P1,14), pw3); \
    l_reg+=sacc; \
    if(GK){DMA_K((t)+3,sl_cur);} if(GV){DMA_V((t)+1,sl_next);} \
    CMASK(C0,C1,t); \
    { float a=MX3(C0[0],C0[1],C1[0]),b=MX3(C0[2],C0[3],C1[1]); a=MX3(a,C1[2],C1[3]); \
      _Pragma("unroll") for(int r=4;r<16;r+=4){a=MX3(a,C0[r],C0[r+1]);b=MX3(b,C0[r+2],C0[r+3]);a=MX3(a,C1[r],C1[r+1]);b=MX3(b,C1[r+2],C1[r+3]);} \
      float rm=__builtin_fmaxf(a,b); { auto rr=__builtin_amdgcn_permlane32_swap(__float_as_uint(rm),__float_as_uint(rm),false,false); rm=__builtin_fmaxf(__uint_as_float(rr[0]),__uint_as_float(rr[1])); } \
      resc=false; \
      if(__builtin_expect(__any(rm>(float)THRL),0)){ const float dl=__builtin_fmaxf(rm,0.f); mhat+=dl; \
        _Pragma("unroll") for(int r=0;r<16;++r){C0[r]-=dl;C1[r]-=dl;} \
        _Pragma("unroll") for(int r=0;r<16;++r)negm[r]=-mhat; asm volatile("":"+v"(negm)); \
        const float f=__builtin_amdgcn_exp2f(-dl); l_reg*=f; if(hi==0)wsf[r32]=f; resc=true; } } \
    SBAR(); \
    GAPB(o[0]=__builtin_amdgcn_mfma_f32_32x32x16_bf16(PAF(0),VFR(0),o[0],0,0,0), C0,0); \
    GAPB(o[1]=__builtin_amdgcn_mfma_f32_32x32x16_bf16(PAF(0),VFR(4),o[1],0,0,0), C0,4); \
    KRD(GL,0); GAPB(o[0]=__builtin_amdgcn_mfma_f32_32x32x16_bf16(PAF(1),VFR(1),o[0],0,0,0), C0,8); \
    KRD(GL,1); GAPB(o[1]=__builtin_amdgcn_mfma_f32_32x32x16_bf16(PAF(1),VFR(5),o[1],0,0,0), C0,12); \
    KRD(GL,2); GAPB(o[0]=__builtin_amdgcn_mfma_f32_32x32x16_bf16(PAF(2),VFR(2),o[0],0,0,0), C1,0); \
    KRD(GL,3); GAPB(o[1]=__builtin_amdgcn_mfma_f32_32x32x16_bf16(PAF(2),VFR(6),o[1],0,0,0), C1,4); \
    GAPB(o[0]=__builtin_amdgcn_mfma_f32_32x32x16_bf16(PAF(3),VFR(3),o[0],0,0,0), C1,8); \
    GAPB(o[1]=__builtin_amdgcn_mfma_f32_32x32x16_bf16(PAF(3),VFR(7),o[1],0,0,0), C1,12); \
    }while(0)
  int t=1;
  #undef CMASK
  #define CMASK(P0,P1,t) do{}while(0)
  for(;t+5<NT;t+=2){
    STEP(pB0,pB1,pA0,pA1,t,true,true,true);     WAIT_BAR(2); RESC(); ROT();
    STEP(pA0,pA1,pB0,pB1,t+1,true,true,true);   WAIT_BAR(2); RESC(); ROT();
  }
  #undef CMASK
  #define CMASK(P0,P1,t) do{int jb_=(t)-(NT-4); if(jb_>=0)cmask(P0,P1,jb_,qrel,hi);}while(0)
  #define ENDW(tt) do{ if((tt)+3<NT){WAIT_BAR(2);} else if((tt)+2<NT){WAIT_BAR(1);} else {WAIT_BAR(0);} }while(0)
  for(;t+1<NT;t+=2){
    STEP(pB0,pB1,pA0,pA1,t,(t+3<NT),(t+1<NT),(t+1<NT));       ENDW(t);   RESC(); ROT();
    STEP(pA0,pA1,pB0,pB1,t+1,(t+4<NT),(t+2<NT),(t+2<NT));     ENDW(t+1); RESC(); ROT();
  }
  STEP(pB0,pB1,pA0,pA1,NT-1,false,false,false); RESC();
  { float sacc=pB0[0]+pB0[1]; _Pragma("unroll") for(int r=2;r<16;++r)sacc+=pB0[r]; _Pragma("unroll") for(int r=0;r<16;++r)sacc+=pB1[r]; l_reg+=sacc;
    pw0=(u32x4){PKW(pB0,0),PKW(pB0,2),PKW(pB0,4),PKW(pB0,6)};pw1=(u32x4){PKW(pB0,8),PKW(pB0,10),PKW(pB0,12),PKW(pB0,14)};pw2=(u32x4){PKW(pB1,0),PKW(pB1,2),PKW(pB1,4),PKW(pB1,6)};pw3=(u32x4){PKW(pB1,8),PKW(pB1,10),PKW(pB1,12),PKW(pB1,14)};
    SBAR(); pv(o,vb0+sl_cur,PAF(0),PAF(1),PAF(2),PAF(3)); }
  #undef PKW
  #undef PAF
  #undef VFR
  #undef PIN
  #undef MX3
  #undef GAPA
  #undef GAPB
  #undef EX
  #undef VRD
  #undef KRD
  #undef STEP
  #undef ENDW
  {auto rr=__builtin_amdgcn_permlane32_swap(__float_as_uint(l_reg),__float_as_uint(l_reg),false,false);l_reg=__uint_as_float(rr[0])+__uint_as_float(rr[1]);}
  if(hi==0)wsf[32+r32]=l_reg;asm volatile("s_waitcnt lgkmcnt(0)":::"memory");
  float rli[16];
  #pragma unroll
  for(int r=0;r<16;++r)rli[r]=__builtin_amdgcn_rcpf(wsf[32+crow(r,hi)]);
  bf16*Ow=O+(rowbase+q0+wid*QBLK)*PO;
  { bf16*stg=(bf16*)(shm+LDS_OST)+wid*2048;
    #pragma unroll
    for(int r=0;r<16;++r){const int orow=crow(r,hi);
      #pragma unroll
      for(int d0=0;d0<2;++d0)stg[orow*64+d0*32+r32]=__float2bfloat16(o[d0][r]*rli[r]);}
    asm volatile("s_waitcnt lgkmcnt(0)":::"memory");
    #pragma unroll
    for(int i=0;i<4;++i){const int row=i*8+(lane>>3),ch=lane&7; const u32x4 v=*(const u32x4*)(stg+row*64+ch*8); ATTN_STORE16(Ow+(long)row*PO+ch*8,v);} }
  asm volatile("s_waitcnt lgkmcnt(0)\n\ts_barrier":::"memory");
  #undef DMA_K
  #undef DMA_V
  #undef CMASK
  #undef START
  #undef RESC
  #undef ROT
}
#undef SBAR
#undef WAIT_BAR
}

#ifndef REPK
#define REPK -1
#endif
#ifndef REPN
#define REPN 0
#endif
#ifndef REPDRY
#define REPDRY 0
#endif
struct Args { const float* in[19]; float* out; unsigned char* ws; int ph_lo, ph_hi; unsigned char prog[48]; };
enum { I_X = 0, I_C, I_WADA, I_BADA, I_GPRE, I_GPOST, I_WIN, I_POOLW, I_POOLS, I_HLB, I_HNORM, I_CONVW, I_DLAM, I_DNORM, I_WMP, I_WMH, I_WMC, I_WMD, I_WOUT };

__global__ void __launch_bounds__(NTHR, 2) fwd_kernel(Args args) {
    extern __shared__ __attribute__((aligned(16))) unsigned char lds_raw[];
    LAS unsigned char* lds = (LAS unsigned char*)lds_raw;
    const int wave0 = __builtin_amdgcn_readfirstlane((int)threadIdx.x >> 6), bx0 = blockIdx.x;
    const int G = gridDim.x;
#if !MK_MULTI
    if (args.ph_hi > 4096) cg::this_grid().sync();
#endif

    XcdBarrier xbar;
    {
        volatile LAS unsigned* st = (volatile LAS unsigned*)((LAS unsigned char*)lds_raw + LDS_BYTES - 64);
        const int tid_s = (int)threadIdx.x;
        if (tid_s == 0) { st[0] = 0u; st[1] = 0u; }
        __syncthreads();
        xbar = xcd_barrier_post((unsigned*)(args.ws + WS_BAR), st, tid_s);
    }
    for (int ph = args.ph_lo; ph < args.ph_hi; ++ph) {
        int bx = bx0; size_t zoff = 0;
        asm volatile("" : "+s"(bx)); asm volatile("" : "+s"(zoff));
        unsigned char* ws = args.ws + zoff;
        const int vcu = (G % 8 == 0) ? (bx % 8) * (G / 8) + bx / 8 : bx;
        const int NGW = G * NWAVES;
        float* MOD = (float*)(ws + WS_MOD); float* SSQ = (float*)(ws + WS_S); float* DEC = (float*)(ws + WS_DEC);
        bf16_t* WIN = (bf16_t*)(ws + WS_WIN); bf16_t* WMRG = (bf16_t*)(ws + WS_WMRG); bf16_t* WOUT = (bf16_t*)(ws + WS_WOUT);
        bf16_t* H = (bf16_t*)(ws + WS_H); bf16_t* OUTB = H; bf16_t* OB = (bf16_t*)(ws + WS_O); bf16_t* MRG = OB;
        float* SB = (float*)(ws + WS_S); bf16_t* P = (bf16_t*)(ws + WS_P);
#define PHASE_IDS unsigned ones_ = ~0u; asm volatile("" : "+s"(ones_)); \
        const int tid = wave0 * 64 + (int)__builtin_amdgcn_mbcnt_hi(ones_, __builtin_amdgcn_mbcnt_lo(ones_, 0u)); \
        const int lane = tid & 63, wave = wave0, gw = bx * NWAVES + wave0; (void)lane; (void)wave; (void)gw
        const int code = __builtin_amdgcn_readfirstlane((int)args.prog[ph]); const int kind = code & 15, l = (code >> 4) & 1, dry = (code >> 6) & 1, nobar = code >> 7;
        const float* xin = (l == 0) ? args.in[I_X] : args.out;

        if (kind == 0 || (kind == 9 && l == 0 && !dry)) {
            PHASE_IDS;
            const int wl = (kind == 0) ? 0 : 1;
            if (kind == 0) {
                LAS float* CA = (LAS float*)(lds + 81920); LAS float* PS = CA + 4096;
                for (int i = tid; i < 4096; i += NTHR) CA[i] = siluf_(args.in[I_C][i]);
                __syncthreads();
                for (int u = bx; u < 192; u += G) {
                    const int ml = u / 96, j0 = (u % 96) * 32;
                    const int jj = tid & 31, ig = tid >> 5;
                    float a0 = 0.f, a1 = 0.f, a2 = 0.f, a3 = 0.f;
                    const float* wp = args.in[I_WADA] + (size_t)ml * 1024 * 3072 + j0 + jj;
#pragma unroll 16
                    for (int i = ig * 64; i < ig * 64 + 64; ++i) { const float w = __builtin_nontemporal_load(wp + (size_t)i * 3072); a0 += CA[i] * w; a1 += CA[1024 + i] * w; a2 += CA[2048 + i] * w; a3 += CA[3072 + i] * w; }
                    PS[(ig * 4 + 0) * 32 + jj] = a0; PS[(ig * 4 + 1) * 32 + jj] = a1; PS[(ig * 4 + 2) * 32 + jj] = a2; PS[(ig * 4 + 3) * 32 + jj] = a3;
                    __syncthreads();
                    if (tid < 128) { const int b = tid >> 5; float sacc = 0.f;
#pragma unroll
                        for (int g2 = 0; g2 < 16; ++g2) sacc += PS[(g2 * 4 + b) * 32 + jj];
                        MOD[(size_t)(ml * 4 + b) * 3072 + j0 + jj] = sacc + args.in[I_BADA][ml * 3072 + j0 + jj]; }
                    __syncthreads();
                }
            }
            LAS float* scr = (LAS float*)(lds + wave * 8448);
            constexpr int I_IN = 16 * 272, I_M3 = 4 * 32, I_MD = 8 * 32, I_O = 16 * 32, NITEMS = I_IN + 3 * I_M3 + I_MD + I_O;
            for (int it = gw; it < NITEMS; it += NGW) {
                int r = it;
                if (r < I_IN) { transpose_item<true>(args.in[I_WIN] + (size_t)wl * 1024 * DIN, 1024, DIN, WIN, scr, r, lane); continue; } r -= I_IN;
                if (r < I_M3) { transpose_item<false, 512>(args.in[I_WMP] + (size_t)wl * 256 * 1024, 256, 1024, WMRG, scr, r, lane); continue; } r -= I_M3;
                if (r < I_M3) { transpose_item<false, 512>(args.in[I_WMH] + (size_t)wl * 256 * 1024, 256, 1024, WMRG + 1024 * 512, scr, r, lane); continue; } r -= I_M3;
                if (r < I_M3) { transpose_item<false, 512>(args.in[I_WMC] + (size_t)wl * 256 * 1024, 256, 1024, WMRG + 2 * 1024 * 512, scr, r, lane); continue; } r -= I_M3;
                if (r < I_MD) { transpose_item<false, 512>(args.in[I_WMD] + (size_t)wl * 512 * 1024, 512, 1024, WMRG + 3 * 1024 * 512, scr, r, lane); continue; } r -= I_MD;
                transpose_item<false>(args.in[I_WOUT] + (size_t)wl * 1024 * 1024, 1024, 1024, WOUT, scr, r, lane);
            }
        }
        if (kind == 1) {
            PHASE_IDS;
            for (int m0r = gw; m0r < M; m0r += 4 * NGW) {
                f32x4 v[4][4]; float s[4];
#pragma unroll
                for (int r = 0; r < 4; ++r) { const int m = m0r + r * NGW; const f32x4* xr = (const f32x4*)(xin + (size_t)m * D) + lane; s[r] = 0.f;
#pragma unroll
                    for (int j = 0; j < 4; ++j) { v[r][j] = (m < M) ? __builtin_nontemporal_load(xr + 64 * j) : (f32x4){0.f, 0.f, 0.f, 0.f}; s[r] += (v[r][j].x * v[r][j].x + v[r][j].y * v[r][j].y) + (v[r][j].z * v[r][j].z + v[r][j].w * v[r][j].w); } }
#pragma unroll
                for (int o = 1; o < 64; o <<= 1) {
#pragma unroll
                    for (int r = 0; r < 4; ++r) s[r] += shflx(s[r], o, lane); }
#pragma unroll
                for (int r = 0; r < 4; ++r) { const int m = m0r + r * NGW; if (m < M) { const int b = m >> 12;
                    const float rstd = rsqrtf(s[r] * (1.f / D) + EPS);
                    const float* md = MOD + (size_t)(0 * 4 + b) * 3072;
                    u32x2* o8 = (u32x2*)(H + (size_t)m * D) + lane;
#pragma unroll
                    for (int j = 0; j < 4; ++j) { const int col = lane * 4 + 256 * j;
                        const f32x4 g = *(const f32x4*)(args.in[I_GPRE] + col), sh = *(const f32x4*)(md + col), sc = *(const f32x4*)(md + 1024 + col);
                        const f32x4 hh = v[r][j] * rstd * g * (sc + 1.0f) + sh;
                        u32x2 w; w.x = pk2(hh.x, hh.y); w.y = pk2(hh.z, hh.w); o8[64 * j] = w; } } }
            }
        }
        else if (kind == 2) {
            PHASE_IDS;
            pg8::Gemm g{H, WIN, M, 4096, D, D, D}; pg8::StaticOrder S; S.init(M, 4096, G, bx);
            pg8::EpiStore E{P, NP, C_DQ, C_DK, attn_body::C2};
            pg8::gemm_phase<pg8::EpiStore, pg8::StaticOrder, true, true>(tid, lds, g, S, E);
        }
        else if (kind == 3) {
            PHASE_IDS;
            if (bx < (G >> 1)) {
                pg8::Gemm g{H, WIN, M, NP, D, D, D}; pg8::TailOrder S{G >> 1, bx};
                pg8::EpiStore E{P, NP, C_DQ, C_DK, attn_body::C2};
                pg8::gemm_phase<pg8::EpiStore, pg8::TailOrder, true, true>(tid, lds, g, S, E);
            } else {
                LAS float* LF = (LAS float*)lds; LAS bf16_t* KDt = (LAS bf16_t*)(LF + 64 * 65); LAS bf16_t* VT = KDt + 64 * 72;
                const int fr = lane & 15, fq = lane >> 4;
                float* SUPA = (float*)(ws + WS_TAIL); float* SUPD = SUPA + 256 * 4096;
                const int halfG = G >> 1;
                for (int g = bx - halfG; g >= 0 && g < 256; g += (G - halfG)) {
                  f32x4 sup[2] = {(f32x4){0.f, 0.f, 0.f, 0.f}, (f32x4){0.f, 0.f, 0.f, 0.f}}; float dsup = 1.f;
                  for (int ci = 0; ci < 4; ++ci) {
                    const int bh = g >> 4, c = (g & 15) * 4 + ci, unit = bh * 64 + c, b = bh >> 2, h = bh & 3;
                    const size_t m0 = (size_t)b * SEQ + c * 64;
                    const int t = tid >> 3, k0 = (tid & 7) * 8;
                    float z[8], v[8], kk[8];
                    load8(P + (m0 + t) * NP + C_BF + h * 64 + k0, z);
                    load8(P + (m0 + t) * NP + C_BI + h * 64 + k0, v);
#pragma unroll
                    for (int j = 0; j < 8; ++j) { const int k = k0 + j; float lb = 0.f;
                        if (l == 1) { const float l0 = args.in[I_HLB][h * 64 + k], l1 = args.in[I_HLB][256 + h * 64 + k]; lb = sigmoidf_(l1 - l0); }
                        const float sg = sigmoidf_(z[j]), f = lb + (1.0f - lb) * sg;
                        LF[t * 65 + k] = __logf(fmaxf(f, 1e-20f)); kk[j] = (1.0f - lb) * sigmoidf_(-z[j]); VT[tsw(k0 + j, t)] = (bf16_t)f2bf(v[j]); }
                    __syncthreads();
                    cumsum64(LF, tid, lane);
                    __syncthreads();
#pragma unroll
                    for (int j = 0; j < 8; ++j) { const int k = k0 + j; const float bl = LF[63 * 65 + k]; KDt[tsw(k, t)] = (bf16_t)f2bf(kk[j] * __expf(bl - LF[t * 65 + k])); if (t == 63) DEC[(size_t)unit * 64 + k] = __expf(bl); }
                    __syncthreads();
                    { const int kb = wave & 3, vb0 = (wave >> 2) * 2; f32x4 acc[2] = {(f32x4){0.f, 0.f, 0.f, 0.f}, (f32x4){0.f, 0.f, 0.f, 0.f}};
#pragma unroll
                        for (int ks = 0; ks < 2; ++ks) { const bf16x8 af = *(const LAS bf16x8*)(KDt + tsw(kb * 16 + fr, ks * 32 + fq * 8));
#pragma unroll
                            for (int n = 0; n < 2; ++n) { const bf16x8 bfr = *(const LAS bf16x8*)(VT + tsw((vb0 + n) * 16 + fr, ks * 32 + fq * 8));
                                acc[n] = __builtin_amdgcn_mfma_f32_16x16x32_bf16(bfr, af, acc[n], 0, 0, 0); } }
                        float* sp = SB + (size_t)unit * 4096 + (kb * 16 + fr) * 64 + fq * 4;
                        const float dk = __expf(LF[63 * 65 + kb * 16 + fr]); dsup *= dk;
#pragma unroll
                        for (int n = 0; n < 2; ++n) { *(f32x4*)(sp + (vb0 + n) * 16) = acc[n]; sup[n] = sup[n] * dk + acc[n]; } }
                    __syncthreads();
                  }
                  { const int kb = wave & 3, vb0 = (wave >> 2) * 2; float* sa = SUPA + (size_t)g * 4096 + (kb * 16 + fr) * 64 + fq * 4;
#pragma unroll
                    for (int n = 0; n < 2; ++n) *(f32x4*)(sa + (vb0 + n) * 16) = sup[n];
                    if (vb0 == 0 && fq == 0) SUPD[g * 64 + kb * 16 + fr] = dsup; }
                }
            }
        }
        else if (kind == 10) {
            PHASE_IDS;
            {
                for (int w = vcu; w < 1024; w += G) {
                    const int i = w >> 8, v = w & 255, bh = v >> 3, s = v & 7;
                    const int qb = (i & 1) ? 15 - s : s, half = i >> 1;
                    const int b = bh >> 3, h = (bh >> 1) & 3, mp = bh & 1;
                    attn_body::attn_unit<8>(tid, b, qb, (const attn_body::bf16*)(P + C_DQ + h * 128 + mp * 64), (const attn_body::bf16*)(P + C_DK + h * 128 + mp * 64),
                                            (const attn_body::bf16*)(P + C_DV + h * 128 + half * 64), (attn_body::bf16*)(OB + h * 256 + mp * 128 + half * 64), (char*)lds_raw);
                }
                asm volatile("s_waitcnt vmcnt(0) lgkmcnt(0)" ::: "memory");
                __syncthreads();
            }
        }
        else if (kind == 4) {
            PHASE_IDS;
            for (int e = bx * NTHR + tid; e < 65536; e += G * NTHR) {
                const int bh = e >> 12, kv = e & 4095, k = kv >> 6; float run = 0.f;
                float* sp = SB + (size_t)bh * 64 * 4096 + kv; const float* dp = DEC + (size_t)bh * 64 * 64 + k;
                for (int c0 = 0; c0 < 64; c0 += 8) { float a[8], d[8];
#pragma unroll
                    for (int j = 0; j < 8; ++j) { a[j] = sp[(size_t)(c0 + j) * 4096]; d[j] = dp[(c0 + j) * 64]; }
#pragma unroll
                    for (int j = 0; j < 8; ++j) { if (!dry) sp[(size_t)(c0 + j) * 4096] = run; run = d[j] * run + a[j]; } }
                if (dry && run == 12345.678f) sp[0] = run;
            }
        }
        else if (kind == 5) {
            PHASE_IDS;
            {
                LAS float* BQ = (LAS float*)lds; LAS float* EF = BQ + 64 * 65; LAS float* RS = EF + 1280;
                LAS bf16_t* QTb = (LAS bf16_t*)(RS + 128); LAS bf16_t* QEb = QTb + 64 * 72; LAS bf16_t* KIb = QEb + 64 * 72;
                LAS bf16_t* SCb = KIb + 160 * 72; LAS bf16_t* VT = SCb + 64 * 72; LAS bf16_t* ST = VT + 64 * 72;
                const int fr = lane & 15, fq = lane >> 4;
                const float* SUPA = (const float*)(ws + WS_TAIL); const float* SUPD = SUPA + 256 * 4096;
                for (int g = bx; g < 256; g += G) {
                  const int t = tid >> 3, k0 = (tid & 7) * 8, I = t >> 4;
                  f32x4 S0 = (f32x4){0.f, 0.f, 0.f, 0.f}, S1 = S0;
                  { const int gb = (g >> 4) * 16, nprev = g & 15;
#pragma unroll 4
                    for (int j = 0; j < nprev; ++j) { const float* ap = SUPA + (size_t)(gb + j) * 4096 + t * 64 + k0; const float dj = SUPD[(gb + j) * 64 + t];
                        const f32x4 a0 = *(const f32x4*)ap, a1 = *(const f32x4*)(ap + 4); S0 = S0 * dj + a0; S1 = S1 * dj + a1; } }
                  for (int ci = 0; ci < 4; ++ci) {
                    const int bh = g >> 4, c = (g & 15) * 4 + ci, unit = bh * 64 + c, b = bh >> 2, h = bh & 3;
                    const size_t m0 = (size_t)b * SEQ + c * 64;
                    float qs[8], kk[8];
                    { float q[8], z[8], v[8];
                        load8(P + (m0 + t) * NP + C_BQ + h * 64 + k0, q);
                        load8(P + (m0 + t) * NP + C_BF + h * 64 + k0, z);
                        load8(P + (m0 + t) * NP + C_BI + h * 64 + k0, v);
                        const f32x4 s0v = S0, s1v = S1;
                        { const float* ap = SB + (size_t)unit * 4096 + t * 64 + k0; const float dj = DEC[(size_t)unit * 64 + t];
                          const f32x4 a0 = *(const f32x4*)ap, a1 = *(const f32x4*)(ap + 4); S0 = S0 * dj + a0; S1 = S1 * dj + a1; }
#pragma unroll
                        for (int j = 0; j < 8; ++j) { const int k = k0 + j; float lb = 0.f;
                            if (l == 1) { const float l0 = args.in[I_HLB][h * 64 + k], l1 = args.in[I_HLB][256 + h * 64 + k]; lb = sigmoidf_(l1 - l0); }
                            const float sg = sigmoidf_(z[j]), f = lb + (1.0f - lb) * sg;
                            BQ[t * 65 + k] = __logf(fmaxf(f, 1e-20f)); kk[j] = (1.0f - lb) * sigmoidf_(-z[j]); qs[j] = siluf_(q[j]); VT[tsw(k0 + j, t)] = (bf16_t)f2bf(v[j]); }
                        ST[tsw(k0 + 0, t)] = (bf16_t)f2bf(s0v.x); ST[tsw(k0 + 1, t)] = (bf16_t)f2bf(s0v.y); ST[tsw(k0 + 2, t)] = (bf16_t)f2bf(s0v.z); ST[tsw(k0 + 3, t)] = (bf16_t)f2bf(s0v.w);
                        ST[tsw(k0 + 4, t)] = (bf16_t)f2bf(s1v.x); ST[tsw(k0 + 5, t)] = (bf16_t)f2bf(s1v.y); ST[tsw(k0 + 6, t)] = (bf16_t)f2bf(s1v.z); ST[tsw(k0 + 7, t)] = (bf16_t)f2bf(s1v.w); }
                    __syncthreads();
                    cumsum64(BQ, tid, lane);
                    __syncthreads();
                    if (tid < 256) { const int Ib = tid >> 6, k = tid & 63; const float br = (Ib == 0) ? 0.f : BQ[(16 * Ib - 1) * 65 + k];
                        EF[Ib * 64 + k] = __expf(br);
                        for (int J = 0; J <= Ib; ++J) { const float bj = (J == 0) ? 0.f : BQ[(16 * J - 1) * 65 + k]; EF[256 + (Ib * 4 + J) * 64 + k] = __expf(br - bj); } }
                    float qt[8], kt[8];
#pragma unroll
                    for (int j = 0; j < 8; ++j) { const int k = k0 + j; const float br = (I == 0) ? 0.f : BQ[(16 * I - 1) * 65 + k]; const float d = BQ[t * 65 + k] - br;
                        qt[j] = qs[j] * __expf(d); kt[j] = kk[j] * __expf(-d); }
                    *(LAS u32x4*)(QTb + t * 72 + k0) = pack8(qt);
                    __syncthreads();
                    { float qe[8];
#pragma unroll
                        for (int j = 0; j < 8; ++j) qe[j] = qt[j] * EF[I * 64 + k0 + j];
                        *(LAS u32x4*)(QEb + t * 72 + k0) = pack8(qe);
                        for (int Ip = I; Ip < 4; ++Ip) { float ki[8];
#pragma unroll
                            for (int j = 0; j < 8; ++j) ki[j] = kt[j] * EF[256 + (Ip * 4 + I) * 64 + k0 + j];
                            *(LAS u32x4*)(KIb + (8 * Ip * (Ip + 1) + t) * 72 + k0) = pack8(ki); } }
                    __syncthreads();
                    if (wave < 4) {
                        const int Ib = wave; const int trow = Ib * 16 + fr;
                        const bf16x8 a0 = *(const LAS bf16x8*)(QTb + trow * 72 + fq * 8), a1 = *(const LAS bf16x8*)(QTb + trow * 72 + 32 + fq * 8);
                        for (int n = 0; n < 4; ++n) { u32x2 w = (u32x2){0u, 0u};
                            if (n <= Ib) { const LAS bf16_t* kr = KIb + (8 * Ib * (Ib + 1) + n * 16 + fr) * 72 + fq * 8;
                                f32x4 acc = (f32x4){0.f, 0.f, 0.f, 0.f};
                                acc = __builtin_amdgcn_mfma_f32_16x16x32_bf16(*(const LAS bf16x8*)kr, a0, acc, 0, 0, 0);
                                acc = __builtin_amdgcn_mfma_f32_16x16x32_bf16(*(const LAS bf16x8*)(kr + 32), a1, acc, 0, 0, 0);
                                const int sc0 = n * 16 + fq * 4;
                                w.x = pk2(sc0 <= trow ? acc.x : 0.f, sc0 + 1 <= trow ? acc.y : 0.f); w.y = pk2(sc0 + 2 <= trow ? acc.z : 0.f, sc0 + 3 <= trow ? acc.w : 0.f); }
                            *(LAS u32x2*)(SCb + trow * 72 + n * 16 + fq * 4) = w; } }
                    __syncthreads();
                    { const int mt = wave & 3, vb0 = (wave >> 2) * 2, trow = mt * 16 + fr; f32x4 acc[2] = {(f32x4){0.f, 0.f, 0.f, 0.f}, (f32x4){0.f, 0.f, 0.f, 0.f}};
#pragma unroll
                        for (int ks = 0; ks < 2; ++ks) { const bf16x8 af = *(const LAS bf16x8*)(QEb + trow * 72 + ks * 32 + fq * 8);
#pragma unroll
                            for (int n = 0; n < 2; ++n) acc[n] = __builtin_amdgcn_mfma_f32_16x16x32_bf16(*(const LAS bf16x8*)(ST + tsw((vb0 + n) * 16 + fr, ks * 32 + fq * 8)), af, acc[n], 0, 0, 0); }
                        const int nks = (mt >> 1) + 1;
                        for (int ks = 0; ks < nks; ++ks) { const bf16x8 af = *(const LAS bf16x8*)(SCb + trow * 72 + ks * 32 + fq * 8);
#pragma unroll
                            for (int n = 0; n < 2; ++n) acc[n] = __builtin_amdgcn_mfma_f32_16x16x32_bf16(*(const LAS bf16x8*)(VT + tsw((vb0 + n) * 16 + fr, ks * 32 + fq * 8)), af, acc[n], 0, 0, 0); }
                        float ss = (acc[0].x * acc[0].x + acc[0].y * acc[0].y) + (acc[0].z * acc[0].z + acc[0].w * acc[0].w) + (acc[1].x * acc[1].x + acc[1].y * acc[1].y) + (acc[1].z * acc[1].z + acc[1].w * acc[1].w);
                        ss += shflx(ss, 16, lane); ss += shflx(ss, 32, lane);
                        if (fq == 0) RS[(wave >> 2) * 64 + trow] = ss;
                        __syncthreads();
                        const float rs = rsqrtf((RS[trow] + RS[64 + trow]) * (1.f / 64.f) + EPS);
#pragma unroll
                        for (int n = 0; n < 2; ++n) { const int v0 = (vb0 + n) * 16 + fq * 4; const f32x4 gn = *(const f32x4*)(args.in[I_HNORM] + l * 64 + v0);
                            bf16_t* gp = P + (m0 + trow) * NP + C_BG + h * 64 + v0; const u32x2 gw2 = *(const u32x2*)gp; const f32x4 y = acc[n] * rs * gn;
                            u32x2 w; w.x = pk2(y.x * siluf_(__uint_as_float(gw2.x << 16)), y.y * siluf_(__uint_as_float(gw2.x & 0xffff0000u)));
                            w.y = pk2(y.z * siluf_(__uint_as_float(gw2.y << 16)), y.w * siluf_(__uint_as_float(gw2.y & 0xffff0000u)));
                            if (!dry) *(u32x2*)gp = w; } }
                    __syncthreads();
                  }
                }
            }
        }
        else if (kind == 11) {
            PHASE_IDS;
            {
                LAS bf16_t* AT = (LAS bf16_t*)lds;
                LAS bf16_t* WT = (LAS bf16_t*)(lds + 40960);
                LAS bf16_t* PB = (LAS bf16_t*)(lds + 77824);
                for (int i = tid; i < 16384; i += NTHR) { const int g = i >> 12, c = (i >> 6) & 63, d = i & 63; WT[(g * 64 + d) * 72 + c] = (bf16_t)f2bf(args.in[I_POOLW][(size_t)l * 16384 + i]); }
                for (int tile = bx; tile < 256; tile += G) {
                    const size_t m0 = (size_t)tile * 64; const int tb0 = (tile * 64) & (SEQ - 1);
#pragma unroll
                    for (int i = 0; i < 5; ++i) { const int c = tid + NTHR * i, row = c >> 5, ch = c & 31;
                        u32x4 v = (u32x4){0u, 0u, 0u, 0u};
                        if (tb0 + row - 16 >= 0) v = *(const u32x4*)(P + (m0 + row - 16) * NP + C_AIN + ch * 8);
                        *(LAS u32x4*)(AT + row * 256 + ch * 8) = v; }
                    const int wv = tid >> 6, g2 = wv >> 1, th = wv & 1, fr = lane & 15, fq = lane >> 4;
                    u32x2 gt[2][4];
#pragma unroll
                    for (int mi = 0; mi < 2; ++mi)
#pragma unroll
                        for (int ni = 0; ni < 4; ++ni) gt[mi][ni] = *(const u32x2*)(P + (m0 + th * 32 + mi * 16 + fr) * NP + C_AG + g2 * 64 + ni * 16 + fq * 4);
                    __syncthreads();
                    { const int j = tid & 255, g = j >> 6, w = 2 << g, t0 = (tid >> 8) * 32; float sw = 0.f;
                        for (int r = 1; r < w; ++r) sw += bf2f(AT[(16 + t0 - r) * 256 + j]);
                        for (int i = 0; i < 32; ++i) { const int tt = t0 + i, tb = tb0 + tt; const float av = bf2f(AT[(16 + tt) * 256 + j]); sw += av;
                            const int n = (tb + 1 < w) ? tb + 1 : w;
                            PB[tt * 264 + j] = (bf16_t)f2bf(sw / (float)n - av);
                            sw -= bf2f(AT[(16 + tt - w + 1) * 256 + j]); } }
                    __syncthreads();
                    { f32x4 acc[2][4];
#pragma unroll
                        for (int mi = 0; mi < 2; ++mi)
#pragma unroll
                            for (int ni = 0; ni < 4; ++ni) acc[mi][ni] = (f32x4){0.f, 0.f, 0.f, 0.f};
#pragma unroll
                        for (int kk = 0; kk < 2; ++kk) { bf16x8 af[2], bfr[4];
#pragma unroll
                            for (int mi = 0; mi < 2; ++mi) af[mi] = *(const LAS bf16x8*)(PB + (th * 32 + mi * 16 + fr) * 264 + g2 * 64 + kk * 32 + fq * 8);
#pragma unroll
                            for (int ni = 0; ni < 4; ++ni) bfr[ni] = *(const LAS bf16x8*)(WT + (g2 * 64 + ni * 16 + fr) * 72 + kk * 32 + fq * 8);
#pragma unroll
                            for (int mi = 0; mi < 2; ++mi)
#pragma unroll
                                for (int ni = 0; ni < 4; ++ni) acc[mi][ni] = __builtin_amdgcn_mfma_f32_16x16x32_bf16(bfr[ni], af[mi], acc[mi][ni], 0, 0, 0); }
#pragma unroll
                        for (int ni = 0; ni < 4; ++ni) { const f32x4 psc = *(const f32x4*)(args.in[I_POOLS] + l * 256 + g2 * 64 + ni * 16 + fq * 4);
#pragma unroll
                            for (int mi = 0; mi < 2; ++mi) { const u32x2 gw2 = gt[mi][ni]; const f32x4 y = acc[mi][ni] * psc;
                                u32x2 w; w.x = pk2(y.x * siluf_(__uint_as_float(gw2.x << 16)), y.y * siluf_(__uint_as_float(gw2.x & 0xffff0000u)));
                                w.y = pk2(y.z * siluf_(__uint_as_float(gw2.y << 16)), y.w * siluf_(__uint_as_float(gw2.y & 0xffff0000u)));
                                if (!dry) *(u32x2*)(P + (m0 + th * 32 + mi * 16 + fr) * NP + C_AG + g2 * 64 + ni * 16 + fq * 4) = w; } } }
                    __syncthreads();
                }
            }
        }
        else if (kind == 12) {
            PHASE_IDS;
            {
                for (int it = bx * NTHR + tid; it < M * 32; it += G * NTHR) {
                    const int m = it >> 5, ch = (it & 31) * 8, tb = m & (SEQ - 1);
                    const bf16_t* row = P + (size_t)m * NP; float y[8], a[8], c2[8];
                    const float* cw = args.in[I_CONVW] + (size_t)l * 3 * 256 + ch;
                    load8(row + C_CX + ch, a); load8(row + C_CC + ch, c2);
#pragma unroll
                    for (int j = 0; j < 8; ++j) y[j] = cw[512 + j] * a[j] * c2[j];
                    if (tb >= 1) { load8(row - NP + C_CX + ch, a); load8(row - NP + C_CC + ch, c2);
#pragma unroll
                        for (int j = 0; j < 8; ++j) y[j] += cw[256 + j] * a[j] * c2[j]; }
                    if (tb >= 2) { load8(row - 2 * NP + C_CX + ch, a); load8(row - 2 * NP + C_CC + ch, c2);
#pragma unroll
                        for (int j = 0; j < 8; ++j) y[j] += cw[j] * a[j] * c2[j]; }
                    load8(row + C_CB + ch, a); load8(row + C_CG + ch, c2);
#pragma unroll
                    for (int j = 0; j < 8; ++j) y[j] = y[j] * a[j] * siluf_(c2[j]);
                    if (!dry) *(u32x4*)(P + (size_t)m * NP + C_CG + ch) = pack8(y);
                }
            }
        }
        else if (kind == 13) {
            PHASE_IDS;
            {
                const float* lm = args.in[I_DLAM] + (size_t)l * 256;
                const float s1 = wave_sum(lm[lane] * lm[64 + lane], lane), s2 = wave_sum(lm[128 + lane] * lm[192 + lane], lane);
                const float lam_init = 0.8f - 0.6f * expf(-0.3f * (float)l);
                const float lam = expf(s1) - expf(s2) + lam_init;
                const int h = lane >> 4, e0 = (lane & 15) * 8;
                for (int m = gw; m < M; m += NGW) {
                    float o1[8], o2[8], g[8];
                    { const u32x4 w1 = __builtin_nontemporal_load((const u32x4*)(OB + (size_t)m * 1024 + h * 256 + e0)), w2 = __builtin_nontemporal_load((const u32x4*)(OB + (size_t)m * 1024 + h * 256 + 128 + e0)); unpack8(w1, o1); unpack8(w2, o2); }
                    bf16_t* gp = P + (size_t)m * NP + C_DG + h * 128 + e0; load8(gp, g);
                    float ss = 0.f;
#pragma unroll
                    for (int j = 0; j < 8; ++j) { o1[j] -= lam * o2[j]; ss += o1[j] * o1[j]; }
                    ss += shflx(ss, 1, lane); ss += shflx(ss, 2, lane); ss += shflx(ss, 4, lane); ss += shflx(ss, 8, lane);
                    const float rs = rsqrtf(ss * (1.f / 128.f) + EPS) * (1.0f - lam_init);
#pragma unroll
                    for (int j = 0; j < 8; ++j) o1[j] = o1[j] * rs * args.in[I_DNORM][l * 128 + e0 + j] * siluf_(g[j]);
                    if (!dry) *(u32x4*)gp = pack8(o1);
                }
            }
        }
        else if (kind == 6) {
            PHASE_IDS;
            bf16_t* S2 = (bf16_t*)(ws + WS_S); bf16_t* T = (bf16_t*)(ws + WS_TAIL);
            pg8::Gemm g{P, WMRG, M, 4096, 256, NP, 512}; pg8::StaticOrder S; S.init(M, 4096, G, bx);
            pg8::EpiY E{P, S2, T};
            pg8::gemm_phase<pg8::EpiY, pg8::StaticOrder, true, true, true>(tid, lds, g, S, E);
        }
        else if (kind == 7) {
            PHASE_IDS;
            bf16_t* S2 = (bf16_t*)(ws + WS_S); bf16_t* T = (bf16_t*)(ws + WS_TAIL);
            pg8::Gemm g{H, WIN + (size_t)C_MG * D, M, 4096, D, D, D}; pg8::StaticOrder S; S.init(M, 4096, G, bx);
            pg8::EpiGate E{P, S2, T, MRG};
            pg8::gemm_phase<pg8::EpiGate, pg8::StaticOrder, true, true>(tid, lds, g, S, E);
        }
        else if (kind == 15) {
            PHASE_IDS;
            bf16_t* S2 = (bf16_t*)(ws + WS_S); bf16_t* T = (bf16_t*)(ws + WS_TAIL);
            pg8::FusedOrder S{G, bx};
            pg8::EpiY EY{P, S2, T}; pg8::EpiGate EG{P, S2, T, MRG};
            pg8::gemm_phase_fused<pg8::FusedOrder, pg8::EpiY, pg8::EpiGate>(tid, lds, P, H, WMRG, WIN + (size_t)C_MG * D, S, EY, EG);
        }
        else if (kind == 8) {
            PHASE_IDS;
            pg8::Gemm g{MRG, WOUT, M, D, D, D, D}; pg8::StaticOrder S; S.init(M, D, G, bx);
            pg8::EpiOut E{OUTB, SSQ};
            pg8::gemm_phase<pg8::EpiOut, pg8::StaticOrder, true, true>(tid, lds, g, S, E);
        }
        else if (kind == 9) {
            PHASE_IDS;
            for (int m0r = gw; m0r < M; m0r += 2 * NGW) {
                f32x4 v[2][4]; float s[2], ssq[2]; f32x4 xv[2][4]; u32x2 ow[2][4];
#pragma unroll
                for (int r = 0; r < 2; ++r) { const int m = (m0r + r * NGW < M) ? m0r + r * NGW : m0r;
                    ssq[r] = (lane < 16) ? SSQ[(size_t)m * 16 + lane] : 0.f;
                    const f32x4* xr = (const f32x4*)(xin + (size_t)m * D) + lane; const u32x2* ob = (const u32x2*)(OUTB + (size_t)m * D) + lane;
#pragma unroll
                    for (int j = 0; j < 4; ++j) { xv[r][j] = __builtin_nontemporal_load(xr + 64 * j); ow[r][j] = __builtin_nontemporal_load(ob + 64 * j); } }
#pragma unroll
                for (int o = 1; o < 16; o <<= 1) { ssq[0] += shflx(ssq[0], o, lane); ssq[1] += shflx(ssq[1], o, lane); }
#pragma unroll
                for (int r = 0; r < 2; ++r) { const int m = m0r + r * NGW; const int b = ((m < M) ? m : m0r) >> 12;
                    const float rstd = rsqrtf(__int_as_float(__builtin_amdgcn_readfirstlane(__float_as_int(ssq[r]))) * (1.f / D) + EPS);
                    const float* md = MOD + (size_t)(l * 4 + b) * 3072; f32x4* orow = (f32x4*)(args.out + (size_t)m * D) + lane; s[r] = 0.f;
#pragma unroll
                    for (int j = 0; j < 4; ++j) { const int col = lane * 4 + 256 * j; const u32x2 w = ow[r][j];
                        const f32x4 o = (f32x4){__uint_as_float(w.x << 16), __uint_as_float(w.x & 0xffff0000u), __uint_as_float(w.y << 16), __uint_as_float(w.y & 0xffff0000u)};
                        const f32x4 gp = *(const f32x4*)(args.in[I_GPOST] + l * 1024 + col), gt = *(const f32x4*)(md + 2048 + col);
                        v[r][j] = xv[r][j] + gt * (o * rstd * gp); if (!dry && m < M) { __builtin_nontemporal_store(v[r][j], orow + 64 * j); }
                        s[r] += (v[r][j].x * v[r][j].x + v[r][j].y * v[r][j].y) + (v[r][j].z * v[r][j].z + v[r][j].w * v[r][j].w); } }
                if (l == 0 && !dry) {
#pragma unroll
                    for (int o = 1; o < 64; o <<= 1) { s[0] += shflx(s[0], o, lane); s[1] += shflx(s[1], o, lane); }
#pragma unroll
                    for (int r = 0; r < 2; ++r) { const int m = m0r + r * NGW; if (m < M) { const int b = m >> 12;
                        const float rstd2 = rsqrtf(s[r] * (1.f / D) + EPS);
                        const float* md1 = MOD + (size_t)(1 * 4 + b) * 3072;
                        u32x2* o8 = (u32x2*)(H + (size_t)m * D) + lane;
#pragma unroll
                        for (int j = 0; j < 4; ++j) { const int col = lane * 4 + 256 * j;
                            const f32x4 g = *(const f32x4*)(args.in[I_GPRE] + 1024 + col), sh = *(const f32x4*)(md1 + col), sc = *(const f32x4*)(md1 + 1024 + col);
                            const f32x4 hh = v[r][j] * rstd2 * g * (sc + 1.0f) + sh;
                            u32x2 w; w.x = pk2(hh.x, hh.y); w.y = pk2(hh.z, hh.w); o8[64 * j] = w; } } }
                }
            }
        }
#if !MK_MULTI
        if (ph + 1 < args.ph_hi && !nobar) { unsigned ones2 = ~0u; asm volatile("" : "+s"(ones2));
            const int tid2 = wave0 * 64 + (int)__builtin_amdgcn_mbcnt_hi(ones2, __builtin_amdgcn_mbcnt_lo(ones2, 0u));
            xcd_barrier(xbar, tid2); }
#endif
    }
}

extern "C" void kernel_launch(void* const* d_in, const int* in_sizes, int n_in, void* d_out, int out_size, void* d_ws, size_t ws_size, hipStream_t stream) {
    static int grid = 0;
    if (grid == 0) {
        if (n_in != 19 || out_size != M * D || ws_size < WS_END) { fprintf(stderr, "kernel_launch: unexpected shapes (n_in %d out %d ws %zu)\n", n_in, out_size, ws_size); grid = -1; return; }
        int dev = 0, cus = 0, per_cu = 0;
        hipGetDevice(&dev);
        hipDeviceGetAttribute(&cus, hipDeviceAttributeMultiprocessorCount, dev);
        if (hipFuncSetAttribute((const void*)fwd_kernel, hipFuncAttributeMaxDynamicSharedMemorySize, LDS_BYTES) != hipSuccess) { fprintf(stderr, "kernel_launch: hipFuncSetAttribute failed\n"); grid = -1; return; }
        if (hipOccupancyMaxActiveBlocksPerMultiprocessor(&per_cu, (const void*)fwd_kernel, NTHR, LDS_BYTES) != hipSuccess || per_cu < 1) per_cu = 1;
        (void)hipGetLastError();
        grid = cus * per_cu;
        if (grid > 256) grid = 256;
    }
    if (grid < 0) return;
    (void)hipMemsetAsync((char*)d_ws + WS_BAR, 0, 16384, stream);
    Args a{};
    for (int i = 0; i < 19; ++i) a.in[i] = (const float*)d_in[i];
    a.out = (float*)d_out; a.ws = (unsigned char*)d_ws;
    int nph = 0;
    auto push = [&](int k, int l, int nobar) { a.prog[nph++] = (unsigned char)(k | (l << 4) | (nobar << 7)); if (k == REPK) for (int r = 0; r < REPN; ++r) a.prog[nph++] = (unsigned char)(k | (l << 4) | (REPDRY << 6) | (nobar << 7)); };
    push(0, 0, 0); push(1, 0, 0);
    for (int l = 0; l < 2; ++l) { push(2, l, 0); push(3, l, 1); push(10, l, 0); push(5, l, 1); push(11, l, 1); push(12, l, 1); push(13, l, 0); push(15, l, 0); push(8, l, 0); push(9, l, 0); }
    if (REPK == 14) for (int r = 0; r < REPN; ++r) a.prog[nph++] = 14;
#if MK_MULTI
    for (int ph = 0; ph < nph; ++ph) { a.ph_lo = ph; a.ph_hi = ph + 1; hipLaunchKernelGGL(fwd_kernel, dim3(grid), dim3(NTHR), LDS_BYTES, stream, a); }
#else
    a.ph_lo = 0; a.ph_hi = nph;
    void* kargs[] = {&a};
    hipError_t e = hipLaunchCooperativeKernel((const void*)fwd_kernel, dim3(grid), dim3(NTHR), kargs, LDS_BYTES, stream);
    if (e != hipSuccess) fprintf(stderr, "cooperative launch failed: %s (grid %d)\n", hipGetErrorString(e), grid);
#endif
}
```

```cpp
#include <hip/hip_runtime.h>
#include <hip/hip_cooperative_groups.h>
#include <hip/hip_bf16.h>
#include <cstdio>
#include <cstdint>
#include <cmath>
namespace cg = cooperative_groups;

#ifndef MK_MULTI
#define MK_MULTI 0
#endif

#define LAS __attribute__((address_space(3)))
typedef unsigned short bf16_t;
typedef short bf16x8 __attribute__((ext_vector_type(8)));
typedef float f32x4 __attribute__((ext_vector_type(4)));
typedef unsigned u32x4 __attribute__((ext_vector_type(4)));
typedef unsigned u32x2 __attribute__((ext_vector_type(2)));

constexpr int M = 16384, SEQ = 4096, D = 1024, DIN = 8704, NP = 4608;
constexpr int C_AIN = 0, C_AG = 256, C_BQ = 512, C_BF = 768, C_BI = 1024, C_BG = 1280, C_CX = 1536, C_CB = 1792, C_CC = 2048, C_CG = 2304,
              C_DQ = 2560, C_DK = 3072, C_DV = 3584, C_DG = 4096, C_MG = 4608;
constexpr float EPS = 1e-6f;
constexpr int NTHR = 512, NWAVES = 8;
constexpr int LDS_BYTES = 147456;
constexpr size_t MiB = 1u << 20;
constexpr size_t WS_MOD = 0, WS_BAR = 128 * 1024, WS_DEC = 256 * 1024;
constexpr size_t WS_WIN = 1 * MiB, WS_WMRG = 18 * MiB  , WS_WOUT = 22 * MiB, WS_H = 24 * MiB, WS_O = 56 * MiB, WS_S = 88 * MiB, WS_P = 104 * MiB, WS_TAIL = 248 * MiB, WS_END = 256 * MiB;

__device__ __forceinline__ float bf2f(unsigned u) { return __uint_as_float(u << 16); }
__device__ __forceinline__ unsigned f2bf(float f) { unsigned u = __float_as_uint(f); return (u + 0x7fffu + ((u >> 16) & 1u)) >> 16; }
__device__ __forceinline__ unsigned pk2(float lo, float hi) { return f2bf(lo) | (f2bf(hi) << 16); }
__device__ __forceinline__ void unpack8(const u32x4 w, float (&f)[8]) {
    f[0] = __uint_as_float(w.x << 16); f[1] = __uint_as_float(w.x & 0xffff0000u); f[2] = __uint_as_float(w.y << 16); f[3] = __uint_as_float(w.y & 0xffff0000u);
    f[4] = __uint_as_float(w.z << 16); f[5] = __uint_as_float(w.z & 0xffff0000u); f[6] = __uint_as_float(w.w << 16); f[7] = __uint_as_float(w.w & 0xffff0000u);
}
__device__ __forceinline__ u32x4 pack8(const float (&f)[8]) { u32x4 w; w.x = pk2(f[0], f[1]); w.y = pk2(f[2], f[3]); w.z = pk2(f[4], f[5]); w.w = pk2(f[6], f[7]); return w; }
__device__ __forceinline__ void load8(const bf16_t* p, float (&f)[8]) { const u32x4 w = *(const u32x4*)p; unpack8(w, f); }
__device__ __forceinline__ float sigmoidf_(float x) { return __builtin_amdgcn_rcpf(1.0f + __builtin_amdgcn_exp2f(-1.4426950408889634f * x)); }
__device__ __forceinline__ float siluf_(float x) { return x * sigmoidf_(x); }
__device__ __forceinline__ float shflx(float v, int mask, int lane) { return __int_as_float(__builtin_amdgcn_ds_bpermute((lane ^ mask) << 2, __float_as_int(v))); }
__device__ __forceinline__ float wave_sum(float v, int lane) {
#pragma unroll
    for (int o = 1; o < 64; o <<= 1) v += shflx(v, o, lane);
    return v;
}
__device__ __forceinline__ int tsw(int row, int col) { return row * 72 + ((((col >> 3) ^ ((row >> 3) & 7)) << 3) | (col & 7)); }
__device__ __forceinline__ void cumsum64(LAS float* LF, int tid, int lane) {
    const int k = tid >> 3, seg = tid & 7; float v[8]; float run = 0.f;
#pragma unroll
    for (int i = 0; i < 8; ++i) { run += LF[(8 * seg + i) * 65 + k]; v[i] = run; }
    float inc = run;
#pragma unroll
    for (int d = 1; d < 8; d <<= 1) { const float o = __int_as_float(__builtin_amdgcn_ds_bpermute((lane - d) << 2, __float_as_int(inc))); if (seg >= d) inc += o; }
    const float off = inc - run;
#pragma unroll
    for (int i = 0; i < 8; ++i) LF[(8 * seg + i) * 65 + k] = v[i] + off;
}
#define XB_TMO      128
#define XB_XCNT(j)  (256  + 64 * (j))
#define XB_XSUB(j)  (1280 + 64 * (j))
#define XB_XGEN(j)  (2304 + 64 * (j))
#define XB_TOP      3328
#define XB_TOPGEN   3392
#define XCD_BAR_WORDS 3456
#define XB_SPIN_CAP (1u << 18)

__device__ __forceinline__ unsigned xb_ld(unsigned* p)              { return __hip_atomic_load(p, __ATOMIC_RELAXED, __HIP_MEMORY_SCOPE_AGENT); }
__device__ __forceinline__ unsigned xb_add(unsigned* p, unsigned v) { return __hip_atomic_fetch_add(p, v, __ATOMIC_RELAXED, __HIP_MEMORY_SCOPE_AGENT); }
__device__ __forceinline__ unsigned xb_xcc_id() { return (unsigned)__builtin_amdgcn_s_getreg((3 << 11) | 20) & 0xFu; }
#define XB_SPIN(cond, bar) do { unsigned _sp = 0; while (cond) { __builtin_amdgcn_s_sleep(1); \
    if ((++_sp & 255u) == 0u) { if (xb_ld(&(bar)[XB_TMO])) break; if (_sp > XB_SPIN_CAP) { atomicAdd(&(bar)[XB_TMO], 1u); break; } } } } while (0)

struct XcdBarrier {
    unsigned* bar; unsigned x;
    volatile LAS unsigned* st;
};

__device__ __forceinline__ XcdBarrier xcd_barrier_post(unsigned* bar, volatile LAS unsigned* st, int tid) {
    XcdBarrier b; b.bar = bar; b.x = xb_xcc_id(); b.st = st;
    if (tid == 0) (void)xb_add(&bar[XB_XCNT(b.x)], 1u);
    return b;
}
__device__ __forceinline__ void xcd_barrier_complete(unsigned* bar, unsigned x, unsigned& nloc, unsigned& nx) {
    const unsigned G = gridDim.x * gridDim.y * gridDim.z;
    unsigned sum, cnt, mine, sp = 0u;
    for (;;) {
        sum = 0u; cnt = 0u; mine = 0u;
#pragma unroll
        for (unsigned j = 0; j < 16; ++j) { const unsigned c = xb_ld(&bar[XB_XCNT(j)]); sum += c; cnt += (c > 0u) ? 1u : 0u; mine = (j == x) ? c : mine; }
        if (sum == G) break;
        __builtin_amdgcn_s_sleep(1);
        if ((++sp & 255u) == 0u) { if (xb_ld(&bar[XB_TMO])) break; if (sp > XB_SPIN_CAP) { atomicAdd(&bar[XB_TMO], 1u); break; } }
    }
    nloc = mine > 0u ? mine : 1u; nx = cnt > 0u ? cnt : 1u;
}

__device__ __forceinline__ void xcd_barrier(const XcdBarrier& b, int tid) {
    asm volatile("s_waitcnt vmcnt(0)" ::: "memory");
    __syncthreads();
    if (tid == 0) {
        unsigned* bar = b.bar;
        __builtin_amdgcn_s_waitcnt(0);
        unsigned nloc = b.st[0], nx = b.st[1];
        if (nloc == 0u) { xcd_barrier_complete(bar, b.x, nloc, nx); b.st[0] = nloc; b.st[1] = nx; }
        const unsigned old = xb_add(&bar[XB_XSUB(b.x)], 1u);
        const unsigned gen = old / nloc;
        if (old + 1u == (gen + 1u) * nloc) {
            __builtin_amdgcn_fence(__ATOMIC_RELEASE, "agent");
            asm volatile("s_waitcnt vmcnt(0)" ::: "memory");
            const unsigned og = xb_add(&bar[XB_TOP], 1u);
            const unsigned tg = og / nx;
            if (og + 1u == (tg + 1u) * nx) xb_add(&bar[XB_TOPGEN], 1u);
            else XB_SPIN(xb_ld(&bar[XB_TOPGEN]) == tg, bar);
            __builtin_amdgcn_fence(__ATOMIC_ACQUIRE, "agent");
            xb_add(&bar[XB_XGEN(b.x)], 1u);
            asm volatile("s_waitcnt vmcnt(0)" ::: "memory");
        } else {
            XB_SPIN(xb_ld(&bar[XB_XGEN(b.x)]) == gen, bar);
            __builtin_amdgcn_fence(__ATOMIC_ACQUIRE, "agent");
            asm volatile("s_waitcnt vmcnt(0)" ::: "memory");
        }
    }
    __syncthreads();
}

__device__ __forceinline__ int win_row(int n) { if (n < 4608) return n; const int g = n - 4608, b = g >> 10, d = g & 1023; return 4608 + 256 * (d >> 6) + 128 * (b >> 1) + 32 * ((d >> 4) & 3) + 16 * (b & 1) + (d & 15); }
template <bool PERMW, int PITCH = 0>
__device__ __forceinline__ void transpose_item(const float* W, int K, int N, bf16_t* WT, LAS float* scr, int item, int lane) {
    const int nblk = N / 32, kb = item / nblk, nb = item % nblk, k0 = 64 * kb, n0 = 32 * nb;
#pragma unroll 8
    for (int i = 0; i < 32; ++i) { const int kk = 2 * i + (lane >> 5); scr[kk * 33 + (lane & 31)] = __builtin_nontemporal_load(W + (size_t)(k0 + kk) * N + n0 + (lane & 31)); }
    asm volatile("s_waitcnt lgkmcnt(0)" ::: "memory");
    const int c = lane & 7;
#pragma unroll
    for (int j = 0; j < 4; ++j) { const int n = (lane >> 3) + 8 * j; const LAS float* s = scr + (8 * c) * 33 + n;
        u32x4 o; o.x = pk2(s[0 * 33], s[1 * 33]); o.y = pk2(s[2 * 33], s[3 * 33]); o.z = pk2(s[4 * 33], s[5 * 33]); o.w = pk2(s[6 * 33], s[7 * 33]);
        *(u32x4*)(WT + (size_t)(PERMW ? win_row(n0 + n) : (n0 + n)) * (PITCH ? PITCH : K) + k0 + 8 * c) = o; }
    asm volatile("s_waitcnt lgkmcnt(0)" ::: "memory");
}

namespace pg8 {
#define PG8_LAS __attribute__((address_space(3)))
typedef unsigned short bf16_t;
typedef short bf16x8 __attribute__((ext_vector_type(8)));
typedef float f32x4 __attribute__((ext_vector_type(4)));
typedef unsigned u32x4 __attribute__((ext_vector_type(4)));
constexpr int BM = 256, BK = 64, HALF = 128, HTB = HALF * BK * 2  , STAGE_BYTES = 8 * HTB, NXCD = 8, WGM = 8;

__host__ __device__ __forceinline__ int lds_byte(int r, int c) { const int st = (r >> 4) * 2 + (c >> 5), rr = r & 15, cc = c & 31, ob = rr * 64 + cc * 2; return st * 1024 + (ob ^ (((ob >> 9) & 1) << 5)); }
__host__ __device__ __forceinline__ void stage_rc(int b, int& R, int& C) { const int st = b / 1024, sb = b % 1024, swz = sb ^ (((sb >> 9) & 1) << 5); R = (st >> 1) * 16 + swz / 64; C = (st & 1) * 32 + (swz % 64) / 2; }
__host__ __device__ __forceinline__ int perm32(int rho) { const int n = rho >> 4, i = rho & 15; return 8 * (i >> 2) + 4 * n + (i & 3); }

typedef unsigned u32x2 __attribute__((ext_vector_type(2)));
struct Unit { int pm, pn; };
struct Gemm { const bf16_t* A; const bf16_t* Bt; int M, N, K, lda, ldb; };

struct StaticOrder {
    int nM, nN, nwg, G, c;
    __host__ __device__ void init(int M, int N, int G_, int c_) { nM = M / BM; nN = N / BM; nwg = nM * nN; G = G_; c = c_; }
    __host__ __device__ bool next(int i, Unit& u) const {
        const long L = (long)i * G + c; if (L >= nwg) return false;
        int wgid = (int)L; { const int q = nwg / NXCD, r = nwg % NXCD, xcd = wgid % NXCD, off = wgid / NXCD; wgid = (xcd < r ? xcd * (q + 1) : r * (q + 1) + (xcd - r) * q) + off; }
        const int nig = WGM * nN, gid = wgid / nig, fm = gid * WGM, gsz = (nM - fm) < WGM ? (nM - fm) : WGM;
        u.pm = fm + ((wgid % nig) % gsz); u.pn = (wgid % nig) / gsz; return true;
    }
    __device__ __forceinline__ void a_ready(const Unit&) const {}
    __device__ __forceinline__ void done(const Unit&) const {}
};


__device__ __forceinline__ bf16_t* yslot(int s, bf16_t* P, bf16_t* S2, bf16_t* T, int& pitch) {
    if (s < 13) { pitch = 4608; const int col = (s == 0) ? 0 : (s <= 3) ? 512 + 256 * (s - 1) : (s <= 6) ? 1536 + 256 * (s - 4) : 2560 + 256 * (s - 7); return P + col; }
    pitch = 256; return (s < 15) ? S2 + (size_t)(s - 13) * 16384 * 256 : T;
}

__device__ __forceinline__ unsigned cvt_pk_bf16(float lo, float hi) { unsigned r; asm volatile("v_cvt_pk_bf16_f32 %0, %1, %2" : "=v"(r) : "v"(lo), "v"(hi)); return r; }
__device__ __forceinline__ float sigm(float x) { return __builtin_amdgcn_rcpf(1.0f + __builtin_amdgcn_exp2f(-1.4426950408889634f * x)); }
struct EpiStore {
    static constexpr bool PERM = true, AFTER_DRAIN = false;
    bf16_t* O; int ldc; int q_lo, q_hi; float qscale;
    __device__ __forceinline__ void operator()(const f32x4 (&acc)[2][2][4][2], const Unit& u, int wr, int wc, int fr, int fq) const {
        const int row0 = u.pm * BM + wr * 64 + fr, colt = u.pn * BM; const bool ntst = !(colt >= q_lo && colt < q_lo + 1536);   const float sc = (colt >= q_lo && colt < q_hi) ? qscale : 1.0f;
        const int col0 = colt + wc * 32 + 8 * fq;
#pragma unroll
        for (int ai = 0; ai < 2; ++ai)
#pragma unroll
            for (int m = 0; m < 4; ++m) { bf16_t* rowp = O + (size_t)(row0 + ai * HALF + m * 16) * ldc + col0;
#pragma unroll
                for (int bj = 0; bj < 2; ++bj) { const f32x4 v0 = acc[ai][bj][m][0] * sc, v1 = acc[ai][bj][m][1] * sc;
                    u32x4 w; w.x = cvt_pk_bf16(v0[0], v0[1]); w.y = cvt_pk_bf16(v0[2], v0[3]); w.z = cvt_pk_bf16(v1[0], v1[1]); w.w = cvt_pk_bf16(v1[2], v1[3]);
                    if (ntst) __builtin_nontemporal_store(w, (u32x4*)(rowp + bj * HALF)); else *(u32x4*)(rowp + bj * HALF) = w; } }
    }
};
struct EpiY {
    static constexpr bool PERM = true, AFTER_DRAIN = false;
    bf16_t* P; bf16_t* S2; bf16_t* T;
    __device__ __forceinline__ void operator()(const f32x4 (&acc)[2][2][4][2], const Unit& u, int wr, int wc, int fr, int fq) const {
        int ldc; bf16_t* O = yslot(u.pn, P, S2, T, ldc);
        const int row0 = u.pm * BM + wr * 64 + fr, col0 = wc * 32 + 8 * fq;
#pragma unroll
        for (int ai = 0; ai < 2; ++ai)
#pragma unroll
            for (int m = 0; m < 4; ++m) { bf16_t* rowp = O + (size_t)(row0 + ai * HALF + m * 16) * ldc + col0;
#pragma unroll
                for (int bj = 0; bj < 2; ++bj) { const f32x4 v0 = acc[ai][bj][m][0], v1 = acc[ai][bj][m][1];
                    u32x4 w; w.x = cvt_pk_bf16(v0[0], v0[1]); w.y = cvt_pk_bf16(v0[2], v0[3]); w.z = cvt_pk_bf16(v1[0], v1[1]); w.w = cvt_pk_bf16(v1[2], v1[3]);
                    *(u32x4*)(rowp + bj * HALF) = w; } }
    }
};
struct EpiGate {
    static constexpr bool PERM = false, AFTER_DRAIN = false;
    bf16_t* P; bf16_t* S2; bf16_t* T; bf16_t* MRG;
    __device__ __forceinline__ void operator()(const f32x4 (&acc)[2][2][4][2], const Unit& u, int wr, int wc, int fr, int fq) const {
        const int sq = u.pn >> 2, chs = (u.pn & 3) * 64 + 16 * wc + 4 * fq;
        const bf16_t* yb[4]; int yp[4];
#pragma unroll
        for (int b = 0; b < 4; ++b) { int pitch; bf16_t* base = yslot(4 * b + sq, P, S2, T, pitch); yb[b] = base + chs; yp[b] = pitch; }
#pragma unroll
        for (int ai = 0; ai < 2; ++ai)
#pragma unroll
            for (int m = 0; m < 4; ++m) { const int row = u.pm * BM + ai * HALF + wr * 64 + m * 16 + fr; f32x4 mg = (f32x4){0.f, 0.f, 0.f, 0.f};
#pragma unroll
                for (int b = 0; b < 4; ++b) { const u32x2 y = *(const u32x2*)(yb[b] + (size_t)row * yp[b]); const f32x4 g = acc[ai][b >> 1][m][b & 1];
                    mg[0] += sigm(g[0]) * __uint_as_float(y.x << 16); mg[1] += sigm(g[1]) * __uint_as_float(y.x & 0xffff0000u);
                    mg[2] += sigm(g[2]) * __uint_as_float(y.y << 16); mg[3] += sigm(g[3]) * __uint_as_float(y.y & 0xffff0000u); }
                u32x2 w; w.x = cvt_pk_bf16(mg[0], mg[1]); w.y = cvt_pk_bf16(mg[2], mg[3]);
                *(u32x2*)(MRG + (size_t)row * 1024 + u.pn * 64 + 16 * wc + 4 * fq) = w; }
    }
};
struct EpiOut {
    static constexpr bool PERM = true, AFTER_DRAIN = false;
    bf16_t* O; float* SSQ;
    __device__ __forceinline__ void operator()(const f32x4 (&acc)[2][2][4][2], const Unit& u, int wr, int wc, int fr, int fq) const {
        const int row0 = u.pm * BM + wr * 64 + fr, col0 = u.pn * BM + wc * 32 + 8 * fq;
#pragma unroll
        for (int ai = 0; ai < 2; ++ai)
#pragma unroll
            for (int m = 0; m < 4; ++m) { const int row = row0 + ai * HALF + m * 16; bf16_t* rowp = O + (size_t)row * 1024 + col0; float ss = 0.f;
#pragma unroll
                for (int bj = 0; bj < 2; ++bj) { const f32x4 v0 = acc[ai][bj][m][0], v1 = acc[ai][bj][m][1];
                    ss += (v0[0] * v0[0] + v0[1] * v0[1]) + (v0[2] * v0[2] + v0[3] * v0[3]) + (v1[0] * v1[0] + v1[1] * v1[1]) + (v1[2] * v1[2] + v1[3] * v1[3]);
                    u32x4 w; w.x = cvt_pk_bf16(v0[0], v0[1]); w.y = cvt_pk_bf16(v0[2], v0[3]); w.z = cvt_pk_bf16(v1[0], v1[1]); w.w = cvt_pk_bf16(v1[2], v1[3]);
                    *(u32x4*)(rowp + bj * HALF) = w; }
                { const int ln = fr + 16 * fq; ss += __int_as_float(__builtin_amdgcn_ds_bpermute((ln ^ 16) << 2, __float_as_int(ss))); ss += __int_as_float(__builtin_amdgcn_ds_bpermute((ln ^ 32) << 2, __float_as_int(ss))); }
                if (fq == 0) SSQ[(size_t)row * 16 + u.pn * 4 + wc] = ss; }
    }
};
template <class Epi, class Sched, bool ALIGN_EPI = false, bool SP2 = false, bool YB = false>
__device__ __forceinline__ void gemm_phase(const int tid, PG8_LAS unsigned char* lds, const Gemm g, const Sched& S, const Epi& E) {
    const int wid = __builtin_amdgcn_readfirstlane(tid >> 6), lane = tid & 63, wr = wid >> 2, wc = wid & 3, fr = lane & 15, fq = lane >> 4;
    int nt = g.K / BK;
    unsigned voffA[2], voffB[2];
#pragma unroll
    for (int i = 0; i < 2; ++i) { int R, C; stage_rc(tid * 16 + i * 8192, R, C); const int Rb = Epi::PERM ? ((R & ~31) + perm32(R & 31)) : R;
        voffA[i] = (unsigned)(R * g.lda + C) * 2u; voffB[i] = (unsigned)(Rb * g.ldb + C) * 2u; }
    const size_t kstep = (size_t)(BK * 2);
    const size_t hstepA = (size_t)HALF * g.lda * 2, hstepB = (size_t)HALF * g.ldb * 2;
    const size_t tstepA = 2 * hstepA, tstepB = 2 * hstepB;
    const unsigned ldsw = (unsigned)wid * 1024u;
    const int aoff = lds_byte(wr * 64 + fr, fq * 8), boff = lds_byte(wc * 32 + fr, fq * 8);
#define PG8_SA(b, h) (((b) * 2 + (h)) * HTB)
#define PG8_SB(b, h) ((4 + (b) * 2 + (h)) * HTB)
#define PG8_STAGE(bufoff, gbase, voff) do { _Pragma("unroll") for (int _i = 0; _i < 2; ++_i) \
        __builtin_amdgcn_global_load_lds((const unsigned*)((const char*)(gbase) + (voff)[_i]), (PG8_LAS unsigned*)(lds + (bufoff) + ldsw + _i * 8192), 16, 0, 0); } while (0)
#define PG8_LDA(dst, b, h) do { _Pragma("unroll") for (int m = 0; m < 4; ++m) _Pragma("unroll") for (int k = 0; k < 2; ++k) dst[m][k] = *(const PG8_LAS bf16x8*)(lds + PG8_SA(b, h) + aoff + m * 2048 + k * 1024); } while (0)
#define PG8_LDB(dst, b, h) do { _Pragma("unroll") for (int n = 0; n < 2; ++n) _Pragma("unroll") for (int k = 0; k < 2; ++k) dst[n][k] = *(const PG8_LAS bf16x8*)(lds + PG8_SB(b, h) + boff + n * 2048 + k * 1024); } while (0)
#define PG8_MMA(ai, bj, At, Bt) do { __builtin_amdgcn_s_setprio(1); _Pragma("unroll") for (int m = 0; m < 4; ++m) _Pragma("unroll") for (int n = 0; n < 2; ++n) _Pragma("unroll") for (int k = 0; k < 2; ++k) \
        acc[ai][bj][m][n] = __builtin_amdgcn_mfma_f32_16x16x32_bf16(Bt[n][k], At[m][k], acc[ai][bj][m][n], 0, 0, 0); __builtin_amdgcn_s_setprio(0); } while (0)
#define PG8_WAIT_V(n) asm volatile("s_waitcnt vmcnt(" #n ")" ::: "memory")
#define PG8_WAIT_L(n) asm volatile("s_waitcnt lgkmcnt(" #n ")" ::: "memory")
#define PG8_BAR __builtin_amdgcn_s_barrier()
#define PG8_SCHED __builtin_amdgcn_sched_barrier(0)
    Unit cur, nxt; int ui = 0;
    if (!S.next(0, cur)) return;
    f32x4 acc[2][2][4][2];
#pragma unroll
    for (int a = 0; a < 2; ++a)
#pragma unroll
        for (int b = 0; b < 2; ++b)
#pragma unroll
            for (int m = 0; m < 4; ++m)
#pragma unroll
                for (int n = 0; n < 2; ++n) acc[a][b][m][n] = (f32x4){0.f, 0.f, 0.f, 0.f};
    bf16x8 At[4][2], B0[2][2], B1[2][2];
#define PG8_APTR(u) (YB ? (const char*)g.A + (size_t)(u).pm * tstepA + 2 * (((u).pn >> 2) == 0 ? 256 : ((u).pn >> 2) == 1 ? 1280 : ((u).pn >> 2) == 2 ? 2304 : 4096) : (const char*)g.A + (size_t)(u).pm * tstepA)
#define PG8_BPTR(u) (YB ? (const char*)g.Bt + (size_t)((u).pn >> 2) * (1024 * 512 * 2) + (size_t)((u).pn & 3) * tstepB : (const char*)g.Bt + (size_t)(u).pn * tstepB)
#define PG8_NT(u) (YB ? ((((u).pn >> 2) == 3) ? 8 : 4) : g.K / BK)
    const char* cA = PG8_APTR(cur); const char* cB = PG8_BPTR(cur); nt = PG8_NT(cur);
    S.a_ready(cur);
    if constexpr (SP2) {
        PG8_STAGE(PG8_SB(0, 0), cB, voffB); PG8_STAGE(PG8_SB(0, 1), cB + hstepB, voffB); PG8_STAGE(PG8_SA(0, 0), cA, voffA); PG8_STAGE(PG8_SA(0, 1), cA + hstepA, voffA);
        if (wr == 1) PG8_BAR;
        PG8_WAIT_V(2); PG8_BAR;
        PG8_STAGE(PG8_SB(1, 0), cB + kstep, voffB); PG8_STAGE(PG8_SA(1, 0), cA + kstep, voffA); PG8_STAGE(PG8_SB(1, 1), cB + hstepB + kstep, voffB);
        PG8_WAIT_V(6); PG8_BAR;
    } else {
        PG8_STAGE(PG8_SB(0, 0), cB, voffB); PG8_STAGE(PG8_SA(0, 0), cA, voffA); PG8_STAGE(PG8_SB(0, 1), cB + hstepB, voffB); PG8_STAGE(PG8_SA(0, 1), cA + hstepA, voffA);
        if (wr == 1) PG8_BAR;
        PG8_WAIT_V(4); PG8_BAR;
        PG8_STAGE(PG8_SB(1, 0), cB + kstep, voffB); PG8_STAGE(PG8_SA(1, 0), cA + kstep, voffA); PG8_STAGE(PG8_SB(1, 1), cB + hstepB + kstep, voffB);
        PG8_WAIT_V(6); PG8_BAR;
    }
    for (;;) {
        const bool has_next = S.next(ui + 1, nxt);
        const char* nA = has_next ? PG8_APTR(nxt) : cA; const char* nB = has_next ? PG8_BPTR(nxt) : cB;
        for (int t = 0; t < nt; t += 2) {
            const bool last = (t == nt - 2);
            const char* a1 = cA + (size_t)(t + 1) * kstep;
            const char* a2 = last ? nA : cA + (size_t)(t + 2) * kstep; const char* b2 = last ? nB : cB + (size_t)(t + 2) * kstep;
            const char* a3 = a2 + kstep; const char* b3 = b2 + kstep;
            if (last && has_next) S.a_ready(nxt);
            if constexpr (SP2) {
            PG8_LDB(B0, 0, 0); PG8_LDB(B1, 0, 1); PG8_SCHED; PG8_LDA(At, 0, 0); PG8_STAGE(PG8_SA(1, 1), a1 + hstepA, voffA);
            PG8_WAIT_V(8); PG8_WAIT_L(0); PG8_BAR; PG8_MMA(0, 0, At, B0); PG8_MMA(0, 1, At, B1); PG8_BAR; PG8_SCHED;
            PG8_LDA(At, 0, 1); PG8_STAGE(PG8_SB(0, 0), b2, voffB); PG8_STAGE(PG8_SB(0, 1), b2 + hstepB, voffB); PG8_STAGE(PG8_SA(0, 0), a2, voffA);
            PG8_WAIT_V(8); PG8_WAIT_L(0); PG8_BAR; PG8_MMA(1, 0, At, B0); PG8_MMA(1, 1, At, B1); PG8_BAR; PG8_SCHED;
            PG8_LDB(B0, 1, 0); PG8_LDB(B1, 1, 1); PG8_SCHED; PG8_LDA(At, 1, 0); PG8_STAGE(PG8_SA(0, 1), a2 + hstepA, voffA);
            PG8_WAIT_V(8); PG8_WAIT_L(0); PG8_BAR; PG8_MMA(0, 0, At, B0); PG8_MMA(0, 1, At, B1); PG8_BAR; PG8_SCHED;
            PG8_LDA(At, 1, 1); PG8_STAGE(PG8_SB(1, 0), b3, voffB); PG8_STAGE(PG8_SB(1, 1), b3 + hstepB, voffB); PG8_STAGE(PG8_SA(1, 0), a3, voffA);
            PG8_WAIT_V(8); PG8_WAIT_L(0); PG8_BAR; PG8_MMA(1, 0, At, B0); PG8_MMA(1, 1, At, B1); PG8_BAR; PG8_SCHED;
            } else {
            PG8_LDB(B0, 0, 0); PG8_SCHED; PG8_LDA(At, 0, 0); PG8_STAGE(PG8_SA(1, 1), a1 + hstepA, voffA);
            PG8_WAIT_L(8); PG8_BAR; PG8_WAIT_L(0); PG8_MMA(0, 0, At, B0); PG8_BAR; PG8_SCHED;
            PG8_LDB(B1, 0, 1); PG8_STAGE(PG8_SB(0, 0), b2, voffB);
            PG8_BAR; PG8_WAIT_L(0); PG8_MMA(0, 1, At, B1); PG8_BAR;
            PG8_LDA(At, 0, 1); PG8_STAGE(PG8_SA(0, 0), a2, voffA);
            PG8_BAR; PG8_WAIT_L(0); PG8_MMA(1, 0, At, B0); PG8_BAR; PG8_SCHED;
            PG8_STAGE(PG8_SB(0, 1), b2 + hstepB, voffB);
            PG8_WAIT_V(6); PG8_BAR; PG8_MMA(1, 1, At, B1); PG8_BAR;
            PG8_LDB(B0, 1, 0); PG8_SCHED; PG8_LDA(At, 1, 0); PG8_STAGE(PG8_SA(0, 1), a2 + hstepA, voffA);
            PG8_WAIT_L(8); PG8_BAR; PG8_WAIT_L(0); PG8_MMA(0, 0, At, B0); PG8_BAR; PG8_SCHED;
            PG8_LDB(B1, 1, 1); PG8_STAGE(PG8_SB(1, 0), b3, voffB);
            PG8_BAR; PG8_WAIT_L(0); PG8_MMA(0, 1, At, B1); PG8_BAR;
            PG8_LDA(At, 1, 1); PG8_STAGE(PG8_SA(1, 0), a3, voffA);
            PG8_BAR; PG8_WAIT_L(0); PG8_MMA(1, 0, At, B0); PG8_BAR; PG8_SCHED;
            PG8_STAGE(PG8_SB(1, 1), b3 + hstepB, voffB);
            PG8_WAIT_V(6); PG8_BAR; PG8_MMA(1, 1, At, B1); PG8_BAR;
            }
        }
        if constexpr (ALIGN_EPI) { if (wr == 0) PG8_BAR; }
        if constexpr (!Epi::AFTER_DRAIN) { E(acc, cur, wr, wc, fr, fq); S.done(cur); }
        if (!has_next) break;
#pragma unroll
        for (int a = 0; a < 2; ++a)
#pragma unroll
            for (int b = 0; b < 2; ++b)
#pragma unroll
                for (int m = 0; m < 4; ++m)
#pragma unroll
                    for (int n = 0; n < 2; ++n) acc[a][b][m][n] = (f32x4){0.f, 0.f, 0.f, 0.f};
        cur = nxt; cA = nA; cB = nB; ++ui; nt = PG8_NT(cur);
        if constexpr (ALIGN_EPI) { if (wr == 1) PG8_BAR; }
    }
    PG8_WAIT_V(0);
    if constexpr (!ALIGN_EPI) { if (wr == 0) PG8_BAR; }
    PG8_BAR;
    if constexpr (Epi::AFTER_DRAIN) { E.fused(acc, cur, wr, wc, fr, fq, lds, wid, lane); S.done(cur); }
#undef PG8_APTR
#undef PG8_BPTR
#undef PG8_NT
#undef PG8_SA
#undef PG8_SB
#undef PG8_STAGE
#undef PG8_LDA
#undef PG8_LDB
#undef PG8_MMA
#undef PG8_WAIT_V
#undef PG8_WAIT_L
#undef PG8_BAR
#undef PG8_SCHED
}

struct FusedOrder {
    int G, c;
    __device__ __forceinline__ bool next(int i, Unit& u) const {
        const int pair = c + (i >> 3) * G; if (pair >= 256) return false;
        const int k = i & 7, x = pair & 7, j = pair >> 3, q = j >> 3;
        u.pm = x * 8 + (j & 7); u.pn = (k < 4) ? 4 * k + q : 16 + 4 * q + (k - 4); return true;
    }
    __device__ __forceinline__ void a_ready(const Unit&) const {}
    __device__ __forceinline__ void done(const Unit&) const {}
};
struct TailOrder {
    int half, c;
    __device__ __forceinline__ bool next(int i, Unit& u) const { const int idx = c + i * half; if (c >= half || idx >= 128) return false; u.pm = idx >> 1; u.pn = 16 + (idx & 1); return true; }
    __device__ __forceinline__ void a_ready(const Unit&) const {}
    __device__ __forceinline__ void done(const Unit&) const {}
};
template <class Sched, class EpiYT, class EpiGT>
__device__ __forceinline__ void gemm_phase_fused(const int tid, PG8_LAS unsigned char* lds, const bf16_t* Pm, const bf16_t* Hm, const bf16_t* Wm, const bf16_t* Wg, const Sched& S, const EpiYT& EY, const EpiGT& EG) {
    constexpr bool ALIGN_EPI = true, SP2 = true;
    const int wid = __builtin_amdgcn_readfirstlane(tid >> 6), lane = tid & 63, wr = wid >> 2, wc = wid & 3, fr = lane & 15, fq = lane >> 4;
    int nt;
    unsigned vAy[2], vAg[2], vBy[2], vBg[2];
#pragma unroll
    for (int i = 0; i < 2; ++i) { int R, C; stage_rc(tid * 16 + i * 8192, R, C); const int Rp = (R & ~31) + perm32(R & 31);
        vAy[i] = (unsigned)(R * ::NP + C) * 2u; vAg[i] = (unsigned)(R * 1024 + C) * 2u; vBy[i] = (unsigned)(Rp * 512 + C) * 2u; vBg[i] = (unsigned)(R * 1024 + C) * 2u; }
    const size_t kstep = (size_t)(BK * 2);
    const size_t hsAy = (size_t)HALF * ::NP * 2, hsAg = (size_t)HALF * 1024 * 2, hsBy = (size_t)HALF * 512 * 2, hsBg = (size_t)HALF * 1024 * 2;
    const unsigned ldsw = (unsigned)wid * 1024u;
    const int aoff = lds_byte(wr * 64 + fr, fq * 8), boff = lds_byte(wc * 32 + fr, fq * 8);
#define PG8_SA(b, h) (((b) * 2 + (h)) * HTB)
#define PG8_SB(b, h) ((4 + (b) * 2 + (h)) * HTB)
#define PG8_STAGE(bufoff, gbase, voff) do { _Pragma("unroll") for (int _i = 0; _i < 2; ++_i) \
        __builtin_amdgcn_global_load_lds((const unsigned*)((const char*)(gbase) + (voff)[_i]), (PG8_LAS unsigned*)(lds + (bufoff) + ldsw + _i * 8192), 16, 0, 0); } while (0)
#define PG8_LDA(dst, b, h) do { _Pragma("unroll") for (int m = 0; m < 4; ++m) _Pragma("unroll") for (int k = 0; k < 2; ++k) dst[m][k] = *(const PG8_LAS bf16x8*)(lds + PG8_SA(b, h) + aoff + m * 2048 + k * 1024); } while (0)
#define PG8_LDB(dst, b, h) do { _Pragma("unroll") for (int n = 0; n < 2; ++n) _Pragma("unroll") for (int k = 0; k < 2; ++k) dst[n][k] = *(const PG8_LAS bf16x8*)(lds + PG8_SB(b, h) + boff + n * 2048 + k * 1024); } while (0)
#define PG8_MMA(ai, bj, At, Bt) do { __builtin_amdgcn_s_setprio(1); _Pragma("unroll") for (int m = 0; m < 4; ++m) _Pragma("unroll") for (int n = 0; n < 2; ++n) _Pragma("unroll") for (int k = 0; k < 2; ++k) \
        acc[ai][bj][m][n] = __builtin_amdgcn_mfma_f32_16x16x32_bf16(Bt[n][k], At[m][k], acc[ai][bj][m][n], 0, 0, 0); __builtin_amdgcn_s_setprio(0); } while (0)
#define PG8_WAIT_V(n) asm volatile("s_waitcnt vmcnt(" #n ")" ::: "memory")
#define PG8_WAIT_L(n) asm volatile("s_waitcnt lgkmcnt(" #n ")" ::: "memory")
#define PG8_BAR __builtin_amdgcn_s_barrier()
#define PG8_SCHED __builtin_amdgcn_sched_barrier(0)
    Unit cur, nxt; int ui = 0;
    if (!S.next(0, cur)) return;
    f32x4 acc[2][2][4][2];
#pragma unroll
    for (int a = 0; a < 2; ++a)
#pragma unroll
        for (int b = 0; b < 2; ++b)
#pragma unroll
            for (int m = 0; m < 4; ++m)
#pragma unroll
                for (int n = 0; n < 2; ++n) acc[a][b][m][n] = (f32x4){0.f, 0.f, 0.f, 0.f};
    bf16x8 At[4][2], B0[2][2], B1[2][2];
#define PGF_ISY(u) ((u).pn < 16)
#define PG8_APTR(u) (PGF_ISY(u) ? (const char*)Pm + (size_t)(u).pm * (2 * hsAy) + 2 * (((u).pn >> 2) == 0 ? 256 : ((u).pn >> 2) == 1 ? 1280 : ((u).pn >> 2) == 2 ? 2304 : 4096) : (const char*)Hm + (size_t)(u).pm * (2 * hsAg))
#define PG8_BPTR(u) (PGF_ISY(u) ? (const char*)Wm + (size_t)((u).pn >> 2) * (1024 * 512 * 2) + (size_t)((u).pn & 3) * (2 * hsBy) : (const char*)Wg + (size_t)((u).pn - 16) * (2 * hsBg))
#define PG8_NT(u) (PGF_ISY(u) ? ((((u).pn >> 2) == 3) ? 8 : 4) : 16)
#define PGF_SEL(dst, c, y, g_) do { dst[0] = (c) ? y[0] : g_[0]; dst[1] = (c) ? y[1] : g_[1]; } while (0)
    const char* cA = PG8_APTR(cur); const char* cB = PG8_BPTR(cur); nt = PG8_NT(cur);
    bool cy = PGF_ISY(cur);
    unsigned vAc[2], vBc[2]; PGF_SEL(vAc, cy, vAy, vAg); PGF_SEL(vBc, cy, vBy, vBg);
    size_t hsAc = cy ? hsAy : hsAg, hsBc = cy ? hsBy : hsBg;
    S.a_ready(cur);
    if constexpr (SP2) {
        PG8_STAGE(PG8_SB(0, 0), cB, vBc); PG8_STAGE(PG8_SB(0, 1), cB + hsBc, vBc); PG8_STAGE(PG8_SA(0, 0), cA, vAc); PG8_STAGE(PG8_SA(0, 1), cA + hsAc, vAc);
        if (wr == 1) PG8_BAR;
        PG8_WAIT_V(2); PG8_BAR;
        PG8_STAGE(PG8_SB(1, 0), cB + kstep, vBc); PG8_STAGE(PG8_SA(1, 0), cA + kstep, vAc); PG8_STAGE(PG8_SB(1, 1), cB + hsBc + kstep, vBc);
        PG8_WAIT_V(6); PG8_BAR;
    } else {
        PG8_STAGE(PG8_SB(0, 0), cB, vBc); PG8_STAGE(PG8_SA(0, 0), cA, vAc); PG8_STAGE(PG8_SB(0, 1), cB + hsBc, vBc); PG8_STAGE(PG8_SA(0, 1), cA + hsAc, vAc);
        if (wr == 1) PG8_BAR;
        PG8_WAIT_V(4); PG8_BAR;
        PG8_STAGE(PG8_SB(1, 0), cB + kstep, vBc); PG8_STAGE(PG8_SA(1, 0), cA + kstep, vAc); PG8_STAGE(PG8_SB(1, 1), cB + hsBc + kstep, vBc);
        PG8_WAIT_V(6); PG8_BAR;
    }
    for (;;) {
        const bool has_next = S.next(ui + 1, nxt); const bool ny = has_next ? PGF_ISY(nxt) : cy;
        const char* nA = has_next ? PG8_APTR(nxt) : cA; const char* nB = has_next ? PG8_BPTR(nxt) : cB;
        for (int t = 0; t < nt; t += 2) {
            const bool last = (t == nt - 2); const bool sy = last ? ny : cy;
            unsigned vAn[2], vBn[2]; PGF_SEL(vAn, sy, vAy, vAg); PGF_SEL(vBn, sy, vBy, vBg); const size_t hsAn = sy ? hsAy : hsAg, hsBn = sy ? hsBy : hsBg;
            const char* a1 = cA + (size_t)(t + 1) * kstep;
            const char* a2 = last ? nA : cA + (size_t)(t + 2) * kstep; const char* b2 = last ? nB : cB + (size_t)(t + 2) * kstep;
            const char* a3 = a2 + kstep; const char* b3 = b2 + kstep;
            if (last && has_next) S.a_ready(nxt);
            if constexpr (SP2) {
            PG8_LDB(B0, 0, 0); PG8_LDB(B1, 0, 1); PG8_SCHED; PG8_LDA(At, 0, 0); PG8_STAGE(PG8_SA(1, 1), a1 + hsAc, vAc);
            PG8_WAIT_V(8); PG8_WAIT_L(0); PG8_BAR; PG8_MMA(0, 0, At, B0); PG8_MMA(0, 1, At, B1); PG8_BAR; PG8_SCHED;
            PG8_LDA(At, 0, 1); PG8_STAGE(PG8_SB(0, 0), b2, vBn); PG8_STAGE(PG8_SB(0, 1), b2 + hsBn, vBn); PG8_STAGE(PG8_SA(0, 0), a2, vAn);
            PG8_WAIT_V(8); PG8_WAIT_L(0); PG8_BAR; PG8_MMA(1, 0, At, B0); PG8_MMA(1, 1, At, B1); PG8_BAR; PG8_SCHED;
            PG8_LDB(B0, 1, 0); PG8_LDB(B1, 1, 1); PG8_SCHED; PG8_LDA(At, 1, 0); PG8_STAGE(PG8_SA(0, 1), a2 + hsAn, vAn);
            PG8_WAIT_V(8); PG8_WAIT_L(0); PG8_BAR; PG8_MMA(0, 0, At, B0); PG8_MMA(0, 1, At, B1); PG8_BAR; PG8_SCHED;
            PG8_LDA(At, 1, 1); PG8_STAGE(PG8_SB(1, 0), b3, vBn); PG8_STAGE(PG8_SB(1, 1), b3 + hsBn, vBn); PG8_STAGE(PG8_SA(1, 0), a3, vAn);
            PG8_WAIT_V(8); PG8_WAIT_L(0); PG8_BAR; PG8_MMA(1, 0, At, B0); PG8_MMA(1, 1, At, B1); PG8_BAR; PG8_SCHED;
            } else {
            PG8_LDB(B0, 0, 0); PG8_SCHED; PG8_LDA(At, 0, 0); PG8_STAGE(PG8_SA(1, 1), a1 + hsAc, vAc);
            PG8_WAIT_L(8); PG8_BAR; PG8_WAIT_L(0); PG8_MMA(0, 0, At, B0); PG8_BAR; PG8_SCHED;
            PG8_LDB(B1, 0, 1); PG8_STAGE(PG8_SB(0, 0), b2, vBn);
            PG8_BAR; PG8_WAIT_L(0); PG8_MMA(0, 1, At, B1); PG8_BAR;
            PG8_LDA(At, 0, 1); PG8_STAGE(PG8_SA(0, 0), a2, vAn);
            PG8_BAR; PG8_WAIT_L(0); PG8_MMA(1, 0, At, B0); PG8_BAR; PG8_SCHED;
            PG8_STAGE(PG8_SB(0, 1), b2 + hsBn, vBn);
            PG8_WAIT_V(6); PG8_BAR; PG8_MMA(1, 1, At, B1); PG8_BAR;
            PG8_LDB(B0, 1, 0); PG8_SCHED; PG8_LDA(At, 1, 0); PG8_STAGE(PG8_SA(0, 1), a2 + hsAn, vAn);
            PG8_WAIT_L(8); PG8_BAR; PG8_WAIT_L(0); PG8_MMA(0, 0, At, B0); PG8_BAR; PG8_SCHED;
            PG8_LDB(B1, 1, 1); PG8_STAGE(PG8_SB(1, 0), b3, vBn);
            PG8_BAR; PG8_WAIT_L(0); PG8_MMA(0, 1, At, B1); PG8_BAR;
            PG8_LDA(At, 1, 1); PG8_STAGE(PG8_SA(1, 0), a3, vAn);
            PG8_BAR; PG8_WAIT_L(0); PG8_MMA(1, 0, At, B0); PG8_BAR; PG8_SCHED;
            PG8_STAGE(PG8_SB(1, 1), b3 + hsBn, vBn);
            PG8_WAIT_V(6); PG8_BAR; PG8_MMA(1, 1, At, B1); PG8_BAR;
            }
        }
        if constexpr (ALIGN_EPI) { if (wr == 0) PG8_BAR; }
        if (cy) EY(acc, cur, wr, wc, fr, fq); else { const Unit ug{cur.pm, cur.pn - 16}; EG(acc, ug, wr, wc, fr, fq); }
        if (!has_next) break;
#pragma unroll
        for (int a = 0; a < 2; ++a)
#pragma unroll
            for (int b = 0; b < 2; ++b)
#pragma unroll
                for (int m = 0; m < 4; ++m)
#pragma unroll
                    for (int n = 0; n < 2; ++n) acc[a][b][m][n] = (f32x4){0.f, 0.f, 0.f, 0.f};
        cur = nxt; cA = nA; cB = nB; ++ui; nt = PG8_NT(cur); cy = ny; PGF_SEL(vAc, cy, vAy, vAg); PGF_SEL(vBc, cy, vBy, vBg); hsAc = cy ? hsAy : hsAg; hsBc = cy ? hsBy : hsBg;
        if constexpr (ALIGN_EPI) { if (wr == 1) PG8_BAR; }
    }
    PG8_WAIT_V(0);
    if constexpr (!ALIGN_EPI) { if (wr == 0) PG8_BAR; }
    PG8_BAR;
#undef PGF_ISY
#undef PGF_SEL
#undef PG8_APTR
#undef PG8_BPTR
#undef PG8_NT
#undef PG8_SA
#undef PG8_SB
#undef PG8_STAGE
#undef PG8_LDA
#undef PG8_LDB
#undef PG8_MMA
#undef PG8_WAIT_V
#undef PG8_WAIT_L
#undef PG8_BAR
#undef PG8_SCHED
}
}


namespace attn_body {
using bf16=__hip_bfloat16;
using bf16x8=__attribute__((ext_vector_type(8)))short;
using s16x4=__attribute__((ext_vector_type(4)))short;
using f32x16=__attribute__((ext_vector_type(16)))float;
using u32x4=__attribute__((ext_vector_type(4)))unsigned;
constexpr int SEQ=4096,D=64,PQ=4608,PO=1024;
constexpr int NW=8,QBLK=32,QB=QBLK*NW,KVBLK=64;
__device__ __forceinline__ int crow(int r,int hi){return (r&3)+8*(r>>2)+4*hi;}
#define SBAR() __builtin_amdgcn_sched_barrier(0)
__device__ __forceinline__ void cmask(f32x16&p0,f32x16&p1,int jb,int qrel,int hi){
  const float NEG=-INFINITY; int kb=64*jb+4*hi;
  #pragma unroll
  for(int r=0;r<16;++r){int kv=kb+(r&3)+8*(r>>2); if(kv>qrel)p0[r]=NEG; if(kv+32>qrel)p1[r]=NEG;}
}
constexpr int NSLOT=3, SLOTB=8192;
constexpr int LDS_K=0, LDS_V=NSLOT*SLOTB, LDS_WS=2*NSLOT*SLOTB, LDS_OST=LDS_WS+NW*64*4, LDS_BYTES=LDS_OST+NW*4096;
constexpr float C2=0.125f*1.4426950408889634f;
__device__ __forceinline__ void glds16(const void*sbase,unsigned voff,unsigned lds_dst){unsigned keep;
  asm volatile("s_mov_b32 %0, m0\n\ts_mov_b32 m0, %3\n\ts_nop 0\n\tglobal_load_lds_dwordx4 %1, %2\n\ts_mov_b32 m0, %0":"=&s"(keep):"v"(voff),"s"(sbase),"s"(lds_dst):"memory");}
__device__ __forceinline__ float max3f(float a,float b,float c){float r;asm("v_max3_f32 %0, %1, %2, %3":"=v"(r):"v"(a),"v"(b),"v"(c));return r;}
__device__ __forceinline__ float max2f(float a,float b){float r;asm("v_max_f32_e32 %0, %1, %2":"=v"(r):"v"(a),"v"(b));return r;}
__device__ __forceinline__ float fadd_s(float a,float b){float r;asm("v_add_f32_e32 %0, %1, %2":"=v"(r):"v"(a),"v"(b));return r;}
__device__ __forceinline__ float fsub_s(float a,float b){float r;asm("v_sub_f32_e32 %0, %1, %2":"=v"(r):"v"(a),"v"(b));return r;}
typedef float f32x2_t __attribute__((ext_vector_type(2))); typedef __bf16 bf16x2_t __attribute__((ext_vector_type(2)));
__device__ __forceinline__ unsigned cvtpk_s(float lo,float hi){f32x2_t v={lo,hi};bf16x2_t b=__builtin_convertvector(v,bf16x2_t);return __builtin_bit_cast(unsigned,b);}
#define WAIT_BAR(N) asm volatile("s_waitcnt vmcnt(" #N ") lgkmcnt(0)\n\ts_barrier":::"memory")
__device__ __forceinline__ void qkt(f32x16&p0,f32x16&p1,const char*Kslot,const bf16x8*qr,const f32x16&negm,int r32,int hi){
  const char*kb=Kslot+hi*1024+r32*16;
  #pragma unroll
  for(int d0=0;d0<4;++d0){
    const bf16x8 b0=*reinterpret_cast<const bf16x8*>(kb+d0*2048);
    const bf16x8 b1=*reinterpret_cast<const bf16x8*>(kb+d0*2048+512);
    if(d0==0){p0=__builtin_amdgcn_mfma_f32_32x32x16_bf16(b0,qr[0],negm,0,0,0);p1=__builtin_amdgcn_mfma_f32_32x32x16_bf16(b1,qr[0],negm,0,0,0);}
    else{p0=__builtin_amdgcn_mfma_f32_32x32x16_bf16(b0,qr[d0],p0,0,0,0);p1=__builtin_amdgcn_mfma_f32_32x32x16_bf16(b1,qr[d0],p1,0,0,0);}}
}
typedef __attribute__((address_space(3))) const char* lds_cptr;
typedef short v4i16_t __attribute__((ext_vector_type(4)));
__device__ __forceinline__ void kload8(bf16x8*kf,lds_cptr kp){
  kf[0]=*(const __attribute__((address_space(3))) bf16x8*)(kp);      kf[1]=*(const __attribute__((address_space(3))) bf16x8*)(kp+512);
  kf[2]=*(const __attribute__((address_space(3))) bf16x8*)(kp+2048); kf[3]=*(const __attribute__((address_space(3))) bf16x8*)(kp+2560);
  kf[4]=*(const __attribute__((address_space(3))) bf16x8*)(kp+4096); kf[5]=*(const __attribute__((address_space(3))) bf16x8*)(kp+4608);
  kf[6]=*(const __attribute__((address_space(3))) bf16x8*)(kp+6144); kf[7]=*(const __attribute__((address_space(3))) bf16x8*)(kp+6656);
}
__device__ __forceinline__ void kload2(bf16x8*kf,lds_cptr kp,int j){ kf[2*j]=*(const __attribute__((address_space(3))) bf16x8*)(kp+j*2048); kf[2*j+1]=*(const __attribute__((address_space(3))) bf16x8*)(kp+j*2048+512); }
__device__ __forceinline__ s16x4 vtr(lds_cptr p){ return __builtin_bit_cast(s16x4,__builtin_amdgcn_ds_read_tr16_b64_v4i16((__attribute__((address_space(3))) v4i16_t*)p)); }
__device__ __forceinline__ float rowmax(const f32x16&p0,const f32x16&p1){
  float a=max3f(p0[0],p0[1],p1[0]),b=max3f(p0[2],p0[3],p1[1]);a=max3f(a,p1[2],p1[3]);
  #pragma unroll
  for(int r=4;r<16;r+=4){a=max3f(a,p0[r],p0[r+1]);b=max3f(b,p0[r+2],p0[r+3]);a=max3f(a,p1[r],p1[r+1]);b=max3f(b,p1[r+2],p1[r+3]);}
  const float m=max2f(a,b);
  auto rr=__builtin_amdgcn_permlane32_swap(__float_as_uint(m),__float_as_uint(m),false,false);
  return max2f(__uint_as_float(rr[0]),__uint_as_float(rr[1]));
}
__device__ __forceinline__ void pv(f32x16*o,int vb,bf16x8 pa0,bf16x8 pa1,bf16x8 pa2,bf16x8 pa3){
  #pragma unroll
  for(int d0=0;d0<2;++d0){s16x4 lo[4],hi[4];
    #pragma unroll
    for(int ks=0;ks<4;++ks){
      asm volatile("ds_read_b64_tr_b16 %0,%1 offset:%c2":"=&v"(lo[ks]):"v"(vb),"i"(d0*4096+ks*1024):"memory");
      asm volatile("ds_read_b64_tr_b16 %0,%1 offset:%c2":"=&v"(hi[ks]):"v"(vb),"i"(d0*4096+ks*1024+512):"memory");}
    asm volatile("s_waitcnt lgkmcnt(0)":::"memory");SBAR();
    #define PK(k) (bf16x8){lo[k][0],lo[k][1],lo[k][2],lo[k][3],hi[k][0],hi[k][1],hi[k][2],hi[k][3]}
    o[d0]=__builtin_amdgcn_mfma_f32_32x32x16_bf16(pa0,PK(0),o[d0],0,0,0);
    o[d0]=__builtin_amdgcn_mfma_f32_32x32x16_bf16(pa1,PK(1),o[d0],0,0,0);
    o[d0]=__builtin_amdgcn_mfma_f32_32x32x16_bf16(pa2,PK(2),o[d0],0,0,0);
    o[d0]=__builtin_amdgcn_mfma_f32_32x32x16_bf16(pa3,PK(3),o[d0],0,0,0);
    #undef PK
  }
}
#define ATTN_STORE16(p,v) (*(u32x4*)(p)=(v))
template<int THRL> __device__ __forceinline__ void attn_unit(int tid,int b,int qb,const bf16*Q,const bf16*__restrict__ K,const bf16*__restrict__ V,bf16*O,char*shm){
  const int lane=tid&63,r32=lane&31,hi=lane>>5; const int wid=__builtin_amdgcn_readfirstlane(tid>>6);
  const long rowbase=(long)b*SEQ; const int q0=qb*QB;
  const bf16*Qw=Q+(rowbase+q0+wid*QBLK)*PQ;
  const bf16*Kh=K+rowbase*PQ,*Vh=V+rowbase*PQ;
  const unsigned lds0=(unsigned)(uintptr_t)shm;
  float*wsf=(float*)(shm+LDS_WS)+wid*64;
  const unsigned kvoff=(unsigned)((lane*PQ+wid*8)*2);
  const unsigned vvoff=(unsigned)(((16*(wid&3)+(lane>>2))*PQ+(wid>>2)*32+(lane&3)*8)*2);
  const unsigned kdst=lds0+LDS_K+wid*1024, vdst=lds0+LDS_V+wid*1024;
  #define DMA_K(t,slot) glds16(Kh+(long)(t)*KVBLK*PQ,kvoff,(unsigned)__builtin_amdgcn_readfirstlane(kdst+(slot)))
  #define DMA_V(t,slot) glds16(Vh+(long)(t)*KVBLK*PQ,vvoff,(unsigned)__builtin_amdgcn_readfirstlane(vdst+(slot)))
  const int vb0=(int)(lds0+LDS_V)+((lane>>4)&1)*32+(lane&3)*8+(4*hi+((lane&15)>>2))*64;
  const char*Kbase=shm+LDS_K; bf16x8 kf[8];
  const lds_cptr shm3=(lds_cptr)shm; const lds_cptr kp0=shm3+LDS_K+hi*1024+r32*16; const lds_cptr vp0=shm3+LDS_V+((lane>>4)&1)*32+(lane&3)*8+(4*hi+((lane&15)>>2))*64;
  const int NT=(q0+QB)/KVBLK;
  DMA_K(0,0);DMA_V(0,0);DMA_K(1,SLOTB);
  bf16x8 qr[4];
  #pragma unroll
  for(int d0=0;d0<4;++d0)qr[d0]=*reinterpret_cast<const bf16x8*>(&Qw[(long)r32*PQ+d0*16+hi*8]);
  float mhat=0.f,l_reg=0.f;f32x16 o[2];o[0]=f32x16{};o[1]=f32x16{};f32x16 negm=f32x16{};asm volatile("":"+v"(negm));
  const int qrel=wid*QBLK+r32;
  #define CMASK(P0,P1,t) do{int jb_=(t)-(NT-4); if(jb_>=0)cmask(P0,P1,jb_,qrel,hi);}while(0)
  bool resc=false;
  #define START(P0,P1) do{ const float rm=rowmax(P0,P1); resc=false; \
    { const float dl=rm; mhat=fadd_s(mhat,dl); \
      _Pragma("unroll") for(int r=0;r<16;++r){P0[r]=fsub_s(P0[r],dl);P1[r]=fsub_s(P1[r],dl);} \
      _Pragma("unroll") for(int r=0;r<16;++r)negm[r]=-mhat; asm volatile("":"+v"(negm)); } \
    _Pragma("unroll") for(int r=0;r<16;++r)P0[r]=__builtin_amdgcn_exp2f(P0[r]); }while(0)
  #define RESC() do{ if(resc){ asm volatile("s_waitcnt lgkmcnt(0)":::"memory"); \
      _Pragma("unroll") for(int d_=0;d_<2;++d_) _Pragma("unroll") for(int r=0;r<16;++r)o[d_][r]*=wsf[crow(r,hi)]; } }while(0)
  f32x16 pA0,pA1,pB0,pB1;
  int sl_prev=0,sl_cur=0,sl_next=SLOTB;
  #define ROT() do{sl_prev=sl_cur;sl_cur=sl_next;sl_next=(sl_next==(NSLOT-1)*SLOTB)?0:sl_next+SLOTB;}while(0)
  DMA_K(2,2*SLOTB);
  WAIT_BAR(3);
  qkt(pA0,pA1,Kbase,qr,negm,r32,hi);asm volatile("s_nop 15\n\ts_nop 7":"+v"(pA0),"+v"(pA1));CMASK(pA0,pA1,0);
  START(pA0,pA1);
  _Pragma("unroll") for(int r=0;r<16;++r)pA1[r]=__builtin_amdgcn_exp2f(pA1[r]);
  WAIT_BAR(0);
  DMA_K(3,0);DMA_V(1,SLOTB);
  ROT();
  kload8(kf,kp0+sl_cur);
  WAIT_BAR(2);
  s16x4 vlo[8],vhi[8]; u32x4 pw0,pw1,pw2,pw3;
  #define PKW(P,B) cvtpk_s(P[B],P[B+1])
  #define PAF(k) __builtin_bit_cast(bf16x8,pw##k)
  #define VFR(i) (bf16x8){vlo[i][0],vlo[i][1],vlo[i][2],vlo[i][3],vhi[i][0],vhi[i][1],vhi[i][2],vhi[i][3]}
  #define PIN(x) asm volatile("":"+v"(x))
  #define MX3(a,b,c) __builtin_fmaxf(__builtin_fmaxf((a),(b)),(c))
  #define GAPA(MF,A0,A1,A2,A3,W0,W1,PW) do{ MF; sacc+=A0; sacc+=A1; sacc+=A2; sacc+=A3; PIN(sacc); W0; W1; PIN(PW); SBAR(); }while(0)
  #define EX(v) __builtin_amdgcn_exp2f(v)
  #define GAPB(MF,X,B) do{ MF; X[B]=EX(X[B]); X[B+1]=EX(X[B+1]); X[B+2]=EX(X[B+2]); X[B+3]=EX(X[B+3]); PIN(X); SBAR(); }while(0)
  #define VRD(i) do{ vlo[i]=vtr(vp_+(((i)>>2)*4096+((i)&3)*1024)); vhi[i]=vtr(vp_+(((i)>>2)*4096+((i)&3)*1024+512)); }while(0)
  #define KRD(G,j) do{ if(G){ kload2(kf,kp0+sl_next,j); SBAR(); } }while(0)
  #define STEP(C0,C1,P0,P1,t,GK,GV,GL) do{ SBAR(); \
    const lds_cptr vp_=vp0+sl_prev; \
    VRD(0); SBAR(); float sacc=(P0[0]+P0[1]); \
    GAPA(C0=__builtin_amdgcn_mfma_f32_32x32x16_bf16(kf[0],qr[0],negm,0,0,0), P0[2],P0[3],P0[4],P0[5],     pw0[0]=PKW(P0,0), pw0[1]=PKW(P0,2), pw0); \
    VRD(4); SBAR(); GAPA(C1=__builtin_amdgcn_mfma_f32_32x32x16_bf16(kf[1],qr[0],negm,0,0,0), P0[6],P0[7],P0[8],P0[9],     pw0[2]=PKW(P0,4), pw0[3]=PKW(P0,6), pw0); \
    VRD(1); SBAR(); GAPA(C0=__builtin_amdgcn_mfma_f32_32x32x16_bf16(kf[2],qr[1],C0,0,0,0),   P0[10],P0[11],P0[12],P0[13], pw1[0]=PKW(P0,8), pw1[1]=PKW(P0,10), pw1); \
    VRD(5); SBAR(); GAPA(C1=__builtin_amdgcn_mfma_f32_32x32x16_bf16(kf[3],qr[1],C1,0,0,0),   P0[14],P0[15],P1[0],P1[1],   pw1[2]=PKW(P0,12),pw1[3]=PKW(P0,14), pw1); \
    VRD(2); SBAR(); GAPA(C0=__builtin_amdgcn_mfma_f32_32x32x16_bf16(kf[4],qr[2],C0,0,0,0),   P1[2],P1[3],P1[4],P1[5],     pw2[0]=PKW(P1,0), pw2[1]=PKW(P1,2), pw2); \
    VRD(6); SBAR(); GAPA(C1=__builtin_amdgcn_mfma_f32_32x32x16_bf16(kf[5],qr[2],C1,0,0,0),   P1[6],P1[7],P1[8],P1[9],     pw2[2]=PKW(P1,4), pw2[3]=PKW(P1,6), pw2); \
    VRD(3); SBAR(); GAPA(C0=__builtin_amdgcn_mfma_f32_32x32x16_bf16(kf[6],qr[3],C0,0,0,0),   P1[10],P1[11],P1[12],P1[13], pw3[0]=PKW(P1,8), pw3[1]=PKW(P1,10), pw3); \
    VRD(7); SBAR(); GAPA(C1=__builtin_amdgcn_mfma_f32_32x32x16_bf16(kf[7],qr[3],C1,0,0,0),   P1[14],P1[15],0.f,0.f,       pw3[2]=PKW(P1,12),pw3[3]=PKW(P1,14), pw3); \
    l_reg+=sacc; \
    if(GK){DMA_K((t)+3,sl_cur);} if(GV){DMA_V((t)+1,sl_next);} \
    CMASK(C0,C1,t); \
    { float a=MX3(C0[0],C0[1],C1[0]),b=MX3(C0[2],C0[3],C1[1]); a=MX3(a,C1[2],C1[3]); \
      _Pragma("unroll") for(int r=4;r<16;r+=4){a=MX3(a,C0[r],C0[r+1]);b=MX3(b,C0[r+2],C0[r+3]);a=MX3(a,C1[r],C1[r+1]);b=MX3(b,C1[r+2],C1[r+3]);} \
      float rm=__builtin_fmaxf(a,b); { auto rr=__builtin_amdgcn_permlane32_swap(__float_as_uint(rm),__float_as_uint(rm),false,false); rm=__builtin_fmaxf(__uint_as_float(rr[0]),__uint_as_float(rr[1])); } \
      resc=false; \
      if(__builtin_expect(__any(rm>(float)THRL),0)){ const float dl=__builtin_fmaxf(rm,0.f); mhat+=dl; \
        _Pragma("unroll") for(int r=0;r<16;++r){C0[r]-=dl;C1[r]-=dl;} \
        _Pragma("unroll") for(int r=0;r<16;++r)negm[r]=-mhat; asm volatile("":"+v"(negm)); \
        const float f=__builtin_amdgcn_exp2f(-dl); l_reg*=f; if(hi==0)wsf[r32]=f; resc=true; } } \
    SBAR(); \
    GAPB(o[0]=__builtin_amdgcn_mfma_f32_32x32x16_bf16(PAF(0),VFR(0),o[0],0,0,0), C0,0); \
    GAPB(o[1]=__builtin_amdgcn_mfma_f32_32x32x16_bf16(PAF(0),VFR(4),o[1],0,0,0), C0,4); \
    KRD(GL,0); GAPB(o[0]=__builtin_amdgcn_mfma_f32_32x32x16_bf16(PAF(1),VFR(1),o[0],0,0,0), C0,8); \
    KRD(GL,1); GAPB(o[1]=__builtin_amdgcn_mfma_f32_32x32x16_bf16(PAF(1),VFR(5),o[1],0,0,0), C0,12); \
    KRD(GL,2); GAPB(o[0]=__builtin_amdgcn_mfma_f32_32x32x16_bf16(PAF(2),VFR(2),o[0],0,0,0), C1,0); \
    KRD(GL,3); GAPB(o[1]=__builtin_amdgcn_mfma_f32_32x32x16_bf16(PAF(2),VFR(6),o[1],0,0,0), C1,4); \
    GAPB(o[0]=__builtin_amdgcn_mfma_f32_32x32x16_bf16(PAF(3),VFR(3),o[0],0,0,0), C1,8); \
    GAPB(o[1]=__builtin_amdgcn_mfma_f32_32x32x16_bf16(PAF(3),VFR(7),o[1],0,0,0), C1,12); \
    }while(0)
  int t=1;
  #undef CMASK
  #define CMASK(P0,P1,t) do{}while(0)
  for(;t+5<NT;t+=2){
    STEP(pB0,pB1,pA0,pA1,t,true,true,true);     WAIT_BAR(2); RESC(); ROT();
    STEP(pA0,pA1,pB0,pB1,t+1,true,true,true);   WAIT_BAR(2); RESC(); ROT();
  }
  #undef CMASK
  #define CMASK(P0,P1,t) do{int jb_=(t)-(NT-4); if(jb_>=0)cmask(P0,P1,jb_,qrel,hi);}while(0)
  #define ENDW(tt) do{ if((tt)+3<NT){WAIT_BAR(2);} else if((tt)+2<NT){WAIT_BAR(1);} else {WAIT_BAR(0);} }while(0)
  for(;t+1<NT;t+=2){
    STEP(pB0,pB1,pA0,pA1,t,(t+3<NT),(t+1<NT),(t+1<NT));       ENDW(t);   RESC(); ROT();
    STEP(pA0,pA1,pB0,pB1,t+1,(t+4<NT),(t+2<NT),(t+2<NT));     ENDW(t+1); RESC(); ROT();
  }
  STEP(pB0,pB1,pA0,pA1,NT-1,false,false,false); RESC();
  { float sacc=pB0[0]+pB0[1]; _Pragma("unroll") for(int r=2;r<16;++r)sacc+=pB0[r]; _Pragma("unroll") for(int r=0;r<16;++r)sacc+=pB1[r]; l_reg+=sacc;
    pw0=(u32x4){PKW(pB0,0),PKW(pB0,2),PKW(pB0,4),PKW(pB0,6)};pw1=(u32x4){PKW(pB0,8),PKW(pB0,10),PKW(pB0,12),PKW(pB0,14)};pw2=(u32x4){PKW(pB1,0),PKW(pB1,2),PKW(pB1,4),PKW(pB1,6)};pw3=(u32x4){PKW(pB1,8),PKW(pB1,10),PKW(pB1,12),PKW(pB1,14)};
    SBAR(); pv(o,vb0+sl_cur,PAF(0),PAF(1),PAF(2),PAF(3)); }
  #undef PKW
  #undef PAF
  #undef VFR
  #undef PIN
  #undef MX3
  #undef GAPA
  #undef GAPB
  #undef EX
  #undef VRD
  #undef KRD
  #undef STEP
  #undef ENDW
  {auto rr=__builtin_amdgcn_permlane32_swap(__float_as_uint(l_reg),__float_as_uint(l_reg),false,false);l_reg=__uint_as_float(rr[0])+__uint_as_float(rr[1]);}
  if(hi==0)wsf[32+r32]=l_reg;asm volatile("s_waitcnt lgkmcnt(0)":::"memory");
  float rli[16];
  #pragma unroll
  for(int r=0;r<16;++r)rli[r]=__builtin_amdgcn_rcpf(wsf[32+crow(r,hi)]);
  bf16*Ow=O+(rowbase+q0+wid*QBLK)*PO;
  { bf16*stg=(bf16*)(shm+LDS_OST)+wid*2048;
    #pragma unroll
    for(int r=0;r<16;++r){const int orow=crow(r,hi);
      #pragma unroll
      for(int d0=0;d0<2;++d0)stg[orow*64+d0*32+r32]=__float2bfloat16(o[d0][r]*rli[r]);}
    asm volatile("s_waitcnt lgkmcnt(0)":::"memory");
    #pragma unroll
    for(int i=0;i<4;++i){const int row=i*8+(lane>>3),ch=lane&7; const u32x4 v=*(const u32x4*)(stg+row*64+ch*8); ATTN_STORE16(Ow+(long)row*PO+ch*8,v);} }
  asm volatile("s_waitcnt lgkmcnt(0)\n\ts_barrier":::"memory");
  #undef DMA_K
  #undef DMA_V
  #undef CMASK
  #undef START
  #undef RESC
  #undef ROT
}
#undef SBAR
#undef WAIT_BAR
}

#ifndef REPK
#define REPK -1
#endif
#ifndef REPN
#define REPN 0
#endif
#ifndef REPDRY
#define REPDRY 0
#endif
struct Args { const float* in[19]; float* out; unsigned char* ws; int ph_lo, ph_hi; unsigned char prog[48]; };
enum { I_X = 0, I_C, I_WADA, I_BADA, I_GPRE, I_GPOST, I_WIN, I_POOLW, I_POOLS, I_HLB, I_HNORM, I_CONVW, I_DLAM, I_DNORM, I_WMP, I_WMH, I_WMC, I_WMD, I_WOUT };

__global__ void __launch_bounds__(NTHR, 2) fwd_kernel(Args args) {
    extern __shared__ __attribute__((aligned(16))) unsigned char lds_raw[];
    LAS unsigned char* lds = (LAS unsigned char*)lds_raw;
    const int wave0 = __builtin_amdgcn_readfirstlane((int)threadIdx.x >> 6), bx0 = blockIdx.x;
    const int G = gridDim.x;
#if !MK_MULTI
    if (args.ph_hi > 4096) cg::this_grid().sync();
#endif

    XcdBarrier xbar;
    {
        volatile LAS unsigned* st = (volatile LAS unsigned*)((LAS unsigned char*)lds_raw + LDS_BYTES - 64);
        const int tid_s = (int)threadIdx.x;
        if (tid_s == 0) { st[0] = 0u; st[1] = 0u; }
        __syncthreads();
        xbar = xcd_barrier_post((unsigned*)(args.ws + WS_BAR), st, tid_s);
    }
    for (int ph = args.ph_lo; ph < args.ph_hi; ++ph) {
        int bx = bx0; size_t zoff = 0;
        asm volatile("" : "+s"(bx)); asm volatile("" : "+s"(zoff));
        unsigned char* ws = args.ws + zoff;
        const int vcu = (G % 8 == 0) ? (bx % 8) * (G / 8) + bx / 8 : bx;
        const int NGW = G * NWAVES;
        float* MOD = (float*)(ws + WS_MOD); float* SSQ = (float*)(ws + WS_S); float* DEC = (float*)(ws + WS_DEC);
        bf16_t* WIN = (bf16_t*)(ws + WS_WIN); bf16_t* WMRG = (bf16_t*)(ws + WS_WMRG); bf16_t* WOUT = (bf16_t*)(ws + WS_WOUT);
        bf16_t* H = (bf16_t*)(ws + WS_H); bf16_t* OUTB = H; bf16_t* OB = (bf16_t*)(ws + WS_O); bf16_t* MRG = OB;
        float* SB = (float*)(ws + WS_S); bf16_t* P = (bf16_t*)(ws + WS_P);
#define PHASE_IDS unsigned ones_ = ~0u; asm volatile("" : "+s"(ones_)); \
        const int tid = wave0 * 64 + (int)__builtin_amdgcn_mbcnt_hi(ones_, __builtin_amdgcn_mbcnt_lo(ones_, 0u)); \
        const int lane = tid & 63, wave = wave0, gw = bx * NWAVES + wave0; (void)lane; (void)wave; (void)gw
        const int code = __builtin_amdgcn_readfirstlane((int)args.prog[ph]); const int kind = code & 15, l = (code >> 4) & 1, dry = (code >> 6) & 1, nobar = code >> 7;
        const float* xin = (l == 0) ? args.in[I_X] : args.out;

        if (kind == 0 || (kind == 9 && l == 0 && !dry)) {
            PHASE_IDS;
            const int wl = (kind == 0) ? 0 : 1;
            if (kind == 0) {
                LAS float* CA = (LAS float*)(lds + 81920); LAS float* PS = CA + 4096;
                for (int i = tid; i < 4096; i += NTHR) CA[i] = siluf_(args.in[I_C][i]);
                __syncthreads();
                for (int u = bx; u < 192; u += G) {
                    const int ml = u / 96, j0 = (u % 96) * 32;
                    const int jj = tid & 31, ig = tid >> 5;
                    float a0 = 0.f, a1 = 0.f, a2 = 0.f, a3 = 0.f;
                    const float* wp = args.in[I_WADA] + (size_t)ml * 1024 * 3072 + j0 + jj;
#pragma unroll 16
                    for (int i = ig * 64; i < ig * 64 + 64; ++i) { const float w = __builtin_nontemporal_load(wp + (size_t)i * 3072); a0 += CA[i] * w; a1 += CA[1024 + i] * w; a2 += CA[2048 + i] * w; a3 += CA[3072 + i] * w; }
                    PS[(ig * 4 + 0) * 32 + jj] = a0; PS[(ig * 4 + 1) * 32 + jj] = a1; PS[(ig * 4 + 2) * 32 + jj] = a2; PS[(ig * 4 + 3) * 32 + jj] = a3;
                    __syncthreads();
                    if (tid < 128) { const int b = tid >> 5; float sacc = 0.f;
#pragma unroll
                        for (int g2 = 0; g2 < 16; ++g2) sacc += PS[(g2 * 4 + b) * 32 + jj];
                        MOD[(size_t)(ml * 4 + b) * 3072 + j0 + jj] = sacc + args.in[I_BADA][ml * 3072 + j0 + jj]; }
                    __syncthreads();
                }
            }
            LAS float* scr = (LAS float*)(lds + wave * 8448);
            constexpr int I_IN = 16 * 272, I_M3 = 4 * 32, I_MD = 8 * 32, I_O = 16 * 32, NITEMS = I_IN + 3 * I_M3 + I_MD + I_O;
            for (int it = gw; it < NITEMS; it += NGW) {
                int r = it;
                if (r < I_IN) { transpose_item<true>(args.in[I_WIN] + (size_t)wl * 1024 * DIN, 1024, DIN, WIN, scr, r, lane); continue; } r -= I_IN;
                if (r < I_M3) { transpose_item<false, 512>(args.in[I_WMP] + (size_t)wl * 256 * 1024, 256, 1024, WMRG, scr, r, lane); continue; } r -= I_M3;
                if (r < I_M3) { transpose_item<false, 512>(args.in[I_WMH] + (size_t)wl * 256 * 1024, 256, 1024, WMRG + 1024 * 512, scr, r, lane); continue; } r -= I_M3;
                if (r < I_M3) { transpose_item<false, 512>(args.in[I_WMC] + (size_t)wl * 256 * 1024, 256, 1024, WMRG + 2 * 1024 * 512, scr, r, lane); continue; } r -= I_M3;
                if (r < I_MD) { transpose_item<false, 512>(args.in[I_WMD] + (size_t)wl * 512 * 1024, 512, 1024, WMRG + 3 * 1024 * 512, scr, r, lane); continue; } r -= I_MD;
                transpose_item<false>(args.in[I_WOUT] + (size_t)wl * 1024 * 1024, 1024, 1024, WOUT, scr, r, lane);
            }
        }
        if (kind == 1) {
            PHASE_IDS;
            for (int m0r = gw; m0r < M; m0r += 4 * NGW) {
                f32x4 v[4][4]; float s[4];
#pragma unroll
                for (int r = 0; r < 4; ++r) { const int m = m0r + r * NGW; const f32x4* xr = (const f32x4*)(xin + (size_t)m * D) + lane; s[r] = 0.f;
#pragma unroll
                    for (int j = 0; j < 4; ++j) { v[r][j] = (m < M) ? __builtin_nontemporal_load(xr + 64 * j) : (f32x4){0.f, 0.f, 0.f, 0.f}; s[r] += (v[r][j].x * v[r][j].x + v[r][j].y * v[r][j].y) + (v[r][j].z * v[r][j].z + v[r][j].w * v[r][j].w); } }
#pragma unroll
                for (int o = 1; o < 64; o <<= 1) {
#pragma unroll
                    for (int r = 0; r < 4; ++r) s[r] += shflx(s[r], o, lane); }
#pragma unroll
                for (int r = 0; r < 4; ++r) { const int m = m0r + r * NGW; if (m < M) { const int b = m >> 12;
                    const float rstd = rsqrtf(s[r] * (1.f / D) + EPS);
                    const float* md = MOD + (size_t)(0 * 4 + b) * 3072;
                    u32x2* o8 = (u32x2*)(H + (size_t)m * D) + lane;
#pragma unroll
                    for (int j = 0; j < 4; ++j) { const int col = lane * 4 + 256 * j;
                        const f32x4 g = *(const f32x4*)(args.in[I_GPRE] + col), sh = *(const f32x4*)(md + col), sc = *(const f32x4*)(md + 1024 + col);
                        const f32x4 hh = v[r][j] * rstd * g * (sc + 1.0f) + sh;
                        u32x2 w; w.x = pk2(hh.x, hh.y); w.y = pk2(hh.z, hh.w); o8[64 * j] = w; } } }
            }
        }
        else if (kind == 2) {
            PHASE_IDS;
            pg8::Gemm g{H, WIN, M, 4096, D, D, D}; pg8::StaticOrder S; S.init(M, 4096, G, bx);
            pg8::EpiStore E{P, NP, C_DQ, C_DK, attn_body::C2};
            pg8::gemm_phase<pg8::EpiStore, pg8::StaticOrder, true, true>(tid, lds, g, S, E);
        }
        else if (kind == 3) {
            PHASE_IDS;
            if (bx < (G >> 1)) {
                pg8::Gemm g{H, WIN, M, NP, D, D, D}; pg8::TailOrder S{G >> 1, bx};
                pg8::EpiStore E{P, NP, C_DQ, C_DK, attn_body::C2};
                pg8::gemm_phase<pg8::EpiStore, pg8::TailOrder, true, true>(tid, lds, g, S, E);
            } else {
                LAS float* LF = (LAS float*)lds; LAS bf16_t* KDt = (LAS bf16_t*)(LF + 64 * 65); LAS bf16_t* VT = KDt + 64 * 72;
                const int fr = lane & 15, fq = lane >> 4;
                float* SUPA = (float*)(ws + WS_TAIL); float* SUPD = SUPA + 256 * 4096;
                const int halfG = G >> 1;
                for (int g = bx - halfG; g >= 0 && g < 256; g += (G - halfG)) {
                  f32x4 sup[2] = {(f32x4){0.f, 0.f, 0.f, 0.f}, (f32x4){0.f, 0.f, 0.f, 0.f}}; float dsup = 1.f;
                  float lb8[8];
                  { const int hh = (g >> 4) & 3, kq0 = (tid & 7) * 8;
#pragma unroll
                    for (int j = 0; j < 8; ++j) { lb8[j] = 0.f; if (l == 1) { const float l0 = args.in[I_HLB][hh * 64 + kq0 + j], l1 = args.in[I_HLB][256 + hh * 64 + kq0 + j]; lb8[j] = sigmoidf_(l1 - l0); } } }
                  for (int ci = 0; ci < 4; ++ci) {
                    const int bh = g >> 4, c = (g & 15) * 4 + ci, unit = bh * 64 + c, b = bh >> 2, h = bh & 3;
                    const size_t m0 = (size_t)b * SEQ + c * 64;
                    const int t = tid >> 3, k0 = (tid & 7) * 8;
                    float z[8], v[8], kk[8];
                    load8(P + (m0 + t) * NP + C_BF + h * 64 + k0, z);
                    load8(P + (m0 + t) * NP + C_BI + h * 64 + k0, v);
#pragma unroll
                    for (int j = 0; j < 8; ++j) { const int k = k0 + j; const float lb = lb8[j];
                        const float sg = sigmoidf_(z[j]), f = lb + (1.0f - lb) * sg;
                        LF[t * 65 + k] = __logf(fmaxf(f, 1e-20f)); kk[j] = (1.0f - lb) * sigmoidf_(-z[j]); VT[tsw(k0 + j, t)] = (bf16_t)f2bf(v[j]); }
                    __syncthreads();
                    cumsum64(LF, tid, lane);
                    __syncthreads();
#pragma unroll
                    for (int j = 0; j < 8; ++j) { const int k = k0 + j; const float bl = LF[63 * 65 + k]; KDt[tsw(k, t)] = (bf16_t)f2bf(kk[j] * __expf(bl - LF[t * 65 + k])); if (t == 63) DEC[(size_t)unit * 64 + k] = __expf(bl); }
                    __syncthreads();
                    { const int kb = wave & 3, vb0 = (wave >> 2) * 2; f32x4 acc[2] = {(f32x4){0.f, 0.f, 0.f, 0.f}, (f32x4){0.f, 0.f, 0.f, 0.f}};
#pragma unroll
                        for (int ks = 0; ks < 2; ++ks) { const bf16x8 af = *(const LAS bf16x8*)(KDt + tsw(kb * 16 + fr, ks * 32 + fq * 8));
#pragma unroll
                            for (int n = 0; n < 2; ++n) { const bf16x8 bfr = *(const LAS bf16x8*)(VT + tsw((vb0 + n) * 16 + fr, ks * 32 + fq * 8));
                                acc[n] = __builtin_amdgcn_mfma_f32_16x16x32_bf16(bfr, af, acc[n], 0, 0, 0); } }
                        float* sp = SB + (size_t)unit * 4096 + (kb * 16 + fr) * 64 + fq * 4;
                        const float dk = __expf(LF[63 * 65 + kb * 16 + fr]); dsup *= dk;
#pragma unroll
                        for (int n = 0; n < 2; ++n) { *(f32x4*)(sp + (vb0 + n) * 16) = acc[n]; sup[n] = sup[n] * dk + acc[n]; } }
                    __syncthreads();
                  }
                  { const int kb = wave & 3, vb0 = (wave >> 2) * 2; float* sa = SUPA + (size_t)g * 4096 + (kb * 16 + fr) * 64 + fq * 4;
#pragma unroll
                    for (int n = 0; n < 2; ++n) *(f32x4*)(sa + (vb0 + n) * 16) = sup[n];
                    if (vb0 == 0 && fq == 0) SUPD[g * 64 + kb * 16 + fr] = dsup; }
                }
            }
        }
        else if (kind == 10) {
            PHASE_IDS;
            {
                for (int w = vcu; w < 1024; w += G) {
                    const int i = w >> 8, v = w & 255, bh = v >> 3, s = v & 7;
                    const int qb = (i & 1) ? 15 - s : s, half = i >> 1;
                    const int b = bh >> 3, h = (bh >> 1) & 3, mp = bh & 1;
                    attn_body::attn_unit<8>(tid, b, qb, (const attn_body::bf16*)(P + C_DQ + h * 128 + mp * 64), (const attn_body::bf16*)(P + C_DK + h * 128 + mp * 64),
                                            (const attn_body::bf16*)(P + C_DV + h * 128 + half * 64), (attn_body::bf16*)(OB + h * 256 + mp * 128 + half * 64), (char*)lds_raw);
                }
                asm volatile("s_waitcnt vmcnt(0) lgkmcnt(0)" ::: "memory");
                __syncthreads();
            }
        }
        else if (kind == 4) {
            PHASE_IDS;
            for (int e = bx * NTHR + tid; e < 65536; e += G * NTHR) {
                const int bh = e >> 12, kv = e & 4095, k = kv >> 6; float run = 0.f;
                float* sp = SB + (size_t)bh * 64 * 4096 + kv; const float* dp = DEC + (size_t)bh * 64 * 64 + k;
                for (int c0 = 0; c0 < 64; c0 += 8) { float a[8], d[8];
#pragma unroll
                    for (int j = 0; j < 8; ++j) { a[j] = sp[(size_t)(c0 + j) * 4096]; d[j] = dp[(c0 + j) * 64]; }
#pragma unroll
                    for (int j = 0; j < 8; ++j) { if (!dry) sp[(size_t)(c0 + j) * 4096] = run; run = d[j] * run + a[j]; } }
                if (dry && run == 12345.678f) sp[0] = run;
            }
        }
        else if (kind == 5) {
            PHASE_IDS;
            {
                LAS float* BQ = (LAS float*)lds; LAS float* EF = BQ + 64 * 65; LAS float* RS = EF + 1280;
                LAS bf16_t* QTb = (LAS bf16_t*)(RS + 128); LAS bf16_t* QEb = QTb + 64 * 72; LAS bf16_t* KIb = QEb + 64 * 72;
                LAS bf16_t* SCb = KIb + 160 * 72; LAS bf16_t* VT = SCb + 64 * 72; LAS bf16_t* ST = VT + 64 * 72;
                const int fr = lane & 15, fq = lane >> 4;
                const float* SUPA = (const float*)(ws + WS_TAIL); const float* SUPD = SUPA + 256 * 4096;
                for (int g = bx; g < 256; g += G) {
                  const int t = tid >> 3, k0 = (tid & 7) * 8, I = t >> 4;
                  f32x4 S0 = (f32x4){0.f, 0.f, 0.f, 0.f}, S1 = S0;
                  { const int gb = (g >> 4) * 16, nprev = g & 15;
#pragma unroll 4
                    for (int j = 0; j < nprev; ++j) { const float* ap = SUPA + (size_t)(gb + j) * 4096 + t * 64 + k0; const float dj = SUPD[(gb + j) * 64 + t];
                        const f32x4 a0 = *(const f32x4*)ap, a1 = *(const f32x4*)(ap + 4); S0 = S0 * dj + a0; S1 = S1 * dj + a1; } }
                  float lb8[8];
                  { const int hh = (g >> 4) & 3;
#pragma unroll
                    for (int j = 0; j < 8; ++j) { lb8[j] = 0.f; if (l == 1) { const float l0 = args.in[I_HLB][hh * 64 + k0 + j], l1 = args.in[I_HLB][256 + hh * 64 + k0 + j]; lb8[j] = sigmoidf_(l1 - l0); } } }
                  for (int ci = 0; ci < 4; ++ci) {
                    const int bh = g >> 4, c = (g & 15) * 4 + ci, unit = bh * 64 + c, b = bh >> 2, h = bh & 3;
                    const size_t m0 = (size_t)b * SEQ + c * 64;
                    float qs[8], kk[8];
                    { float q[8], z[8], v[8];
                        load8(P + (m0 + t) * NP + C_BQ + h * 64 + k0, q);
                        load8(P + (m0 + t) * NP + C_BF + h * 64 + k0, z);
                        load8(P + (m0 + t) * NP + C_BI + h * 64 + k0, v);
                        const f32x4 s0v = S0, s1v = S1;
                        { const float* ap = SB + (size_t)unit * 4096 + t * 64 + k0; const float dj = DEC[(size_t)unit * 64 + t];
                          const f32x4 a0 = *(const f32x4*)ap, a1 = *(const f32x4*)(ap + 4); S0 = S0 * dj + a0; S1 = S1 * dj + a1; }
#pragma unroll
                        for (int j = 0; j < 8; ++j) { const int k = k0 + j; const float lb = lb8[j];
                            const float sg = sigmoidf_(z[j]), f = lb + (1.0f - lb) * sg;
                            BQ[t * 65 + k] = __logf(fmaxf(f, 1e-20f)); kk[j] = (1.0f - lb) * sigmoidf_(-z[j]); qs[j] = siluf_(q[j]); VT[tsw(k0 + j, t)] = (bf16_t)f2bf(v[j]); }
                        ST[tsw(k0 + 0, t)] = (bf16_t)f2bf(s0v.x); ST[tsw(k0 + 1, t)] = (bf16_t)f2bf(s0v.y); ST[tsw(k0 + 2, t)] = (bf16_t)f2bf(s0v.z); ST[tsw(k0 + 3, t)] = (bf16_t)f2bf(s0v.w);
                        ST[tsw(k0 + 4, t)] = (bf16_t)f2bf(s1v.x); ST[tsw(k0 + 5, t)] = (bf16_t)f2bf(s1v.y); ST[tsw(k0 + 6, t)] = (bf16_t)f2bf(s1v.z); ST[tsw(k0 + 7, t)] = (bf16_t)f2bf(s1v.w); }
                    __syncthreads();
                    cumsum64(BQ, tid, lane);
                    __syncthreads();
                    if (tid < 256) { const int Ib = tid >> 6, k = tid & 63; const float br = (Ib == 0) ? 0.f : BQ[(16 * Ib - 1) * 65 + k];
                        EF[Ib * 64 + k] = __expf(br);
                        for (int J = 0; J <= Ib; ++J) { const float bj = (J == 0) ? 0.f : BQ[(16 * J - 1) * 65 + k]; EF[256 + (Ib * 4 + J) * 64 + k] = __expf(br - bj); } }
                    float qt[8], kt[8];
#pragma unroll
                    for (int j = 0; j < 8; ++j) { const int k = k0 + j; const float br = (I == 0) ? 0.f : BQ[(16 * I - 1) * 65 + k]; const float d = BQ[t * 65 + k] - br;
                        qt[j] = qs[j] * __expf(d); kt[j] = kk[j] * __expf(-d); }
                    *(LAS u32x4*)(QTb + t * 72 + k0) = pack8(qt);
                    __syncthreads();
                    { float qe[8];
#pragma unroll
                        for (int j = 0; j < 8; ++j) qe[j] = qt[j] * EF[I * 64 + k0 + j];
                        *(LAS u32x4*)(QEb + t * 72 + k0) = pack8(qe);
                        for (int Ip = I; Ip < 4; ++Ip) { float ki[8];
#pragma unroll
                            for (int j = 0; j < 8; ++j) ki[j] = kt[j] * EF[256 + (Ip * 4 + I) * 64 + k0 + j];
                            *(LAS u32x4*)(KIb + (8 * Ip * (Ip + 1) + t) * 72 + k0) = pack8(ki); } }
                    __syncthreads();
                    if (wave < 4) {
                        const int Ib = wave; const int trow = Ib * 16 + fr;
                        const bf16x8 a0 = *(const LAS bf16x8*)(QTb + trow * 72 + fq * 8), a1 = *(const LAS bf16x8*)(QTb + trow * 72 + 32 + fq * 8);
                        for (int n = 0; n < 4; ++n) { u32x2 w = (u32x2){0u, 0u};
                            if (n <= Ib) { const LAS bf16_t* kr = KIb + (8 * Ib * (Ib + 1) + n * 16 + fr) * 72 + fq * 8;
                                f32x4 acc = (f32x4){0.f, 0.f, 0.f, 0.f};
                                acc = __builtin_amdgcn_mfma_f32_16x16x32_bf16(*(const LAS bf16x8*)kr, a0, acc, 0, 0, 0);
                                acc = __builtin_amdgcn_mfma_f32_16x16x32_bf16(*(const LAS bf16x8*)(kr + 32), a1, acc, 0, 0, 0);
                                const int sc0 = n * 16 + fq * 4;
                                w.x = pk2(sc0 <= trow ? acc.x : 0.f, sc0 + 1 <= trow ? acc.y : 0.f); w.y = pk2(sc0 + 2 <= trow ? acc.z : 0.f, sc0 + 3 <= trow ? acc.w : 0.f); }
                            *(LAS u32x2*)(SCb + trow * 72 + n * 16 + fq * 4) = w; } }
                    __syncthreads();
                    { const int mt = wave & 3, vb0 = (wave >> 2) * 2, trow = mt * 16 + fr; f32x4 acc[2] = {(f32x4){0.f, 0.f, 0.f, 0.f}, (f32x4){0.f, 0.f, 0.f, 0.f}};
#pragma unroll
                        for (int ks = 0; ks < 2; ++ks) { const bf16x8 af = *(const LAS bf16x8*)(QEb + trow * 72 + ks * 32 + fq * 8);
#pragma unroll
                            for (int n = 0; n < 2; ++n) acc[n] = __builtin_amdgcn_mfma_f32_16x16x32_bf16(*(const LAS bf16x8*)(ST + tsw((vb0 + n) * 16 + fr, ks * 32 + fq * 8)), af, acc[n], 0, 0, 0); }
                        const int nks = (mt >> 1) + 1;
                        for (int ks = 0; ks < nks; ++ks) { const bf16x8 af = *(const LAS bf16x8*)(SCb + trow * 72 + ks * 32 + fq * 8);
#pragma unroll
                            for (int n = 0; n < 2; ++n) acc[n] = __builtin_amdgcn_mfma_f32_16x16x32_bf16(*(const LAS bf16x8*)(VT + tsw((vb0 + n) * 16 + fr, ks * 32 + fq * 8)), af, acc[n], 0, 0, 0); }
                        float ss = (acc[0].x * acc[0].x + acc[0].y * acc[0].y) + (acc[0].z * acc[0].z + acc[0].w * acc[0].w) + (acc[1].x * acc[1].x + acc[1].y * acc[1].y) + (acc[1].z * acc[1].z + acc[1].w * acc[1].w);
                        ss += shflx(ss, 16, lane); ss += shflx(ss, 32, lane);
                        if (fq == 0) RS[(wave >> 2) * 64 + trow] = ss;
                        __syncthreads();
                        const float rs = rsqrtf((RS[trow] + RS[64 + trow]) * (1.f / 64.f) + EPS);
#pragma unroll
                        for (int n = 0; n < 2; ++n) { const int v0 = (vb0 + n) * 16 + fq * 4; const f32x4 gn = *(const f32x4*)(args.in[I_HNORM] + l * 64 + v0);
                            bf16_t* gp = P + (m0 + trow) * NP + C_BG + h * 64 + v0; const u32x2 gw2 = *(const u32x2*)gp; const f32x4 y = acc[n] * rs * gn;
                            u32x2 w; w.x = pk2(y.x * siluf_(__uint_as_float(gw2.x << 16)), y.y * siluf_(__uint_as_float(gw2.x & 0xffff0000u)));
                            w.y = pk2(y.z * siluf_(__uint_as_float(gw2.y << 16)), y.w * siluf_(__uint_as_float(gw2.y & 0xffff0000u)));
                            if (!dry) *(u32x2*)gp = w; } }
                    __syncthreads();
                  }
                }
            }
        }
        else if (kind == 11) {
            PHASE_IDS;
            {
                LAS bf16_t* AT = (LAS bf16_t*)lds;
                LAS bf16_t* WT = (LAS bf16_t*)(lds + 40960);
                LAS bf16_t* PB = (LAS bf16_t*)(lds + 77824);
                for (int i = tid; i < 16384; i += NTHR) { const int g = i >> 12, c = (i >> 6) & 63, d = i & 63; WT[(g * 64 + d) * 72 + c] = (bf16_t)f2bf(args.in[I_POOLW][(size_t)l * 16384 + i]); }
                for (int tile = bx; tile < 256; tile += G) {
                    const size_t m0 = (size_t)tile * 64; const int tb0 = (tile * 64) & (SEQ - 1);
#pragma unroll
                    for (int i = 0; i < 5; ++i) { const int c = tid + NTHR * i, row = c >> 5, ch = c & 31;
                        u32x4 v = (u32x4){0u, 0u, 0u, 0u};
                        if (tb0 + row - 16 >= 0) v = *(const u32x4*)(P + (m0 + row - 16) * NP + C_AIN + ch * 8);
                        *(LAS u32x4*)(AT + row * 256 + ch * 8) = v; }
                    const int wv = tid >> 6, g2 = wv >> 1, th = wv & 1, fr = lane & 15, fq = lane >> 4;
                    u32x2 gt[2][4];
#pragma unroll
                    for (int mi = 0; mi < 2; ++mi)
#pragma unroll
                        for (int ni = 0; ni < 4; ++ni) gt[mi][ni] = *(const u32x2*)(P + (m0 + th * 32 + mi * 16 + fr) * NP + C_AG + g2 * 64 + ni * 16 + fq * 4);
                    __syncthreads();
                    { const int j = tid & 255, g = j >> 6, w = 2 << g, t0 = (tid >> 8) * 32; float sw = 0.f;
                        for (int r = 1; r < w; ++r) sw += bf2f(AT[(16 + t0 - r) * 256 + j]);
                        for (int i = 0; i < 32; ++i) { const int tt = t0 + i, tb = tb0 + tt; const float av = bf2f(AT[(16 + tt) * 256 + j]); sw += av;
                            const int n = (tb + 1 < w) ? tb + 1 : w;
                            PB[tt * 264 + j] = (bf16_t)f2bf(sw / (float)n - av);
                            sw -= bf2f(AT[(16 + tt - w + 1) * 256 + j]); } }
                    __syncthreads();
                    { f32x4 acc[2][4];
#pragma unroll
                        for (int mi = 0; mi < 2; ++mi)
#pragma unroll
                            for (int ni = 0; ni < 4; ++ni) acc[mi][ni] = (f32x4){0.f, 0.f, 0.f, 0.f};
#pragma unroll
                        for (int kk = 0; kk < 2; ++kk) { bf16x8 af[2], bfr[4];
#pragma unroll
                            for (int mi = 0; mi < 2; ++mi) af[mi] = *(const LAS bf16x8*)(PB + (th * 32 + mi * 16 + fr) * 264 + g2 * 64 + kk * 32 + fq * 8);
#pragma unroll
                            for (int ni = 0; ni < 4; ++ni) bfr[ni] = *(const LAS bf16x8*)(WT + (g2 * 64 + ni * 16 + fr) * 72 + kk * 32 + fq * 8);
#pragma unroll
                            for (int mi = 0; mi < 2; ++mi)
#pragma unroll
                                for (int ni = 0; ni < 4; ++ni) acc[mi][ni] = __builtin_amdgcn_mfma_f32_16x16x32_bf16(bfr[ni], af[mi], acc[mi][ni], 0, 0, 0); }
#pragma unroll
                        for (int ni = 0; ni < 4; ++ni) { const f32x4 psc = *(const f32x4*)(args.in[I_POOLS] + l * 256 + g2 * 64 + ni * 16 + fq * 4);
#pragma unroll
                            for (int mi = 0; mi < 2; ++mi) { const u32x2 gw2 = gt[mi][ni]; const f32x4 y = acc[mi][ni] * psc;
                                u32x2 w; w.x = pk2(y.x * siluf_(__uint_as_float(gw2.x << 16)), y.y * siluf_(__uint_as_float(gw2.x & 0xffff0000u)));
                                w.y = pk2(y.z * siluf_(__uint_as_float(gw2.y << 16)), y.w * siluf_(__uint_as_float(gw2.y & 0xffff0000u)));
                                if (!dry) *(u32x2*)(P + (m0 + th * 32 + mi * 16 + fr) * NP + C_AG + g2 * 64 + ni * 16 + fq * 4) = w; } } }
                    __syncthreads();
                }
            }
        }
        else if (kind == 12) {
            PHASE_IDS;
            {
                for (int it = bx * NTHR + tid; it < M * 32; it += G * NTHR) {
                    const int m = it >> 5, ch = (it & 31) * 8, tb = m & (SEQ - 1);
                    const bf16_t* row = P + (size_t)m * NP; float y[8], a[8], c2[8];
                    const float* cw = args.in[I_CONVW] + (size_t)l * 3 * 256 + ch;
                    load8(row + C_CX + ch, a); load8(row + C_CC + ch, c2);
#pragma unroll
                    for (int j = 0; j < 8; ++j) y[j] = cw[512 + j] * a[j] * c2[j];
                    if (tb >= 1) { load8(row - NP + C_CX + ch, a); load8(row - NP + C_CC + ch, c2);
#pragma unroll
                        for (int j = 0; j < 8; ++j) y[j] += cw[256 + j] * a[j] * c2[j]; }
                    if (tb >= 2) { load8(row - 2 * NP + C_CX + ch, a); load8(row - 2 * NP + C_CC + ch, c2);
#pragma unroll
                        for (int j = 0; j < 8; ++j) y[j] += cw[j] * a[j] * c2[j]; }
                    load8(row + C_CB + ch, a); load8(row + C_CG + ch, c2);
#pragma unroll
                    for (int j = 0; j < 8; ++j) y[j] = y[j] * a[j] * siluf_(c2[j]);
                    if (!dry) *(u32x4*)(P + (size_t)m * NP + C_CG + ch) = pack8(y);
                }
            }
        }
        else if (kind == 13) {
            PHASE_IDS;
            {
                const float* lm = args.in[I_DLAM] + (size_t)l * 256;
                const float s1 = wave_sum(lm[lane] * lm[64 + lane], lane), s2 = wave_sum(lm[128 + lane] * lm[192 + lane], lane);
                const float lam_init = 0.8f - 0.6f * expf(-0.3f * (float)l);
                const float lam = expf(s1) - expf(s2) + lam_init;
                const int h = lane >> 4, e0 = (lane & 15) * 8;
                for (int m = gw; m < M; m += NGW) {
                    float o1[8], o2[8], g[8];
                    { const u32x4 w1 = __builtin_nontemporal_load((const u32x4*)(OB + (size_t)m * 1024 + h * 256 + e0)), w2 = __builtin_nontemporal_load((const u32x4*)(OB + (size_t)m * 1024 + h * 256 + 128 + e0)); unpack8(w1, o1); unpack8(w2, o2); }
                    bf16_t* gp = P + (size_t)m * NP + C_DG + h * 128 + e0; load8(gp, g);
                    float ss = 0.f;
#pragma unroll
                    for (int j = 0; j < 8; ++j) { o1[j] -= lam * o2[j]; ss += o1[j] * o1[j]; }
                    ss += shflx(ss, 1, lane); ss += shflx(ss, 2, lane); ss += shflx(ss, 4, lane); ss += shflx(ss, 8, lane);
                    const float rs = rsqrtf(ss * (1.f / 128.f) + EPS) * (1.0f - lam_init);
#pragma unroll
                    for (int j = 0; j < 8; ++j) o1[j] = o1[j] * rs * args.in[I_DNORM][l * 128 + e0 + j] * siluf_(g[j]);
                    if (!dry) *(u32x4*)gp = pack8(o1);
                }
            }
        }
        else if (kind == 6) {
            PHASE_IDS;
            bf16_t* S2 = (bf16_t*)(ws + WS_S); bf16_t* T = (bf16_t*)(ws + WS_TAIL);
            pg8::Gemm g{P, WMRG, M, 4096, 256, NP, 512}; pg8::StaticOrder S; S.init(M, 4096, G, bx);
            pg8::EpiY E{P, S2, T};
            pg8::gemm_phase<pg8::EpiY, pg8::StaticOrder, true, true, true>(tid, lds, g, S, E);
        }
        else if (kind == 7) {
            PHASE_IDS;
            bf16_t* S2 = (bf16_t*)(ws + WS_S); bf16_t* T = (bf16_t*)(ws + WS_TAIL);
            pg8::Gemm g{H, WIN + (size_t)C_MG * D, M, 4096, D, D, D}; pg8::StaticOrder S; S.init(M, 4096, G, bx);
            pg8::EpiGate E{P, S2, T, MRG};
            pg8::gemm_phase<pg8::EpiGate, pg8::StaticOrder, true, true>(tid, lds, g, S, E);
        }
        else if (kind == 15) {
            PHASE_IDS;
            bf16_t* S2 = (bf16_t*)(ws + WS_S); bf16_t* T = (bf16_t*)(ws + WS_TAIL);
            pg8::FusedOrder S{G, bx};
            pg8::EpiY EY{P, S2, T}; pg8::EpiGate EG{P, S2, T, MRG};
            pg8::gemm_phase_fused<pg8::FusedOrder, pg8::EpiY, pg8::EpiGate>(tid, lds, P, H, WMRG, WIN + (size_t)C_MG * D, S, EY, EG);
        }
        else if (kind == 8) {
            PHASE_IDS;
            pg8::Gemm g{MRG, WOUT, M, D, D, D, D}; pg8::StaticOrder S; S.init(M, D, G, bx);
            pg8::EpiOut E{OUTB, SSQ};
            pg8::gemm_phase<pg8::EpiOut, pg8::StaticOrder, true, true>(tid, lds, g, S, E);
        }
        else if (kind == 9) {
            PHASE_IDS;
            for (int m0r = gw; m0r < M; m0r += 2 * NGW) {
                f32x4 v[2][4]; float s[2], ssq[2]; f32x4 xv[2][4]; u32x2 ow[2][4];
#pragma unroll
                for (int r = 0; r < 2; ++r) { const int m = (m0r + r * NGW < M) ? m0r + r * NGW : m0r;
                    ssq[r] = (lane < 16) ? SSQ[(size_t)m * 16 + lane] : 0.f;
                    const f32x4* xr = (const f32x4*)(xin + (size_t)m * D) + lane; const u32x2* ob = (const u32x2*)(OUTB + (size_t)m * D) + lane;
#pragma unroll
                    for (int j = 0; j < 4; ++j) { xv[r][j] = __builtin_nontemporal_load(xr + 64 * j); ow[r][j] = __builtin_nontemporal_load(ob + 64 * j); } }
#pragma unroll
                for (int o = 1; o < 16; o <<= 1) { ssq[0] += shflx(ssq[0], o, lane); ssq[1] += shflx(ssq[1], o, lane); }
#pragma unroll
                for (int r = 0; r < 2; ++r) { const int m = m0r + r * NGW; const int b = ((m < M) ? m : m0r) >> 12;
                    const float rstd = rsqrtf(__int_as_float(__builtin_amdgcn_readfirstlane(__float_as_int(ssq[r]))) * (1.f / D) + EPS);
                    const float* md = MOD + (size_t)(l * 4 + b) * 3072; f32x4* orow = (f32x4*)(args.out + (size_t)m * D) + lane; s[r] = 0.f;
#pragma unroll
                    for (int j = 0; j < 4; ++j) { const int col = lane * 4 + 256 * j; const u32x2 w = ow[r][j];
                        const f32x4 o = (f32x4){__uint_as_float(w.x << 16), __uint_as_float(w.x & 0xffff0000u), __uint_as_float(w.y << 16), __uint_as_float(w.y & 0xffff0000u)};
                        const f32x4 gp = *(const f32x4*)(args.in[I_GPOST] + l * 1024 + col), gt = *(const f32x4*)(md + 2048 + col);
                        v[r][j] = xv[r][j] + gt * (o * rstd * gp); if (!dry && m < M) { __builtin_nontemporal_store(v[r][j], orow + 64 * j); }
                        s[r] += (v[r][j].x * v[r][j].x + v[r][j].y * v[r][j].y) + (v[r][j].z * v[r][j].z + v[r][j].w * v[r][j].w); } }
                if (l == 0 && !dry) {
#pragma unroll
                    for (int o = 1; o < 64; o <<= 1) { s[0] += shflx(s[0], o, lane); s[1] += shflx(s[1], o, lane); }
#pragma unroll
                    for (int r = 0; r < 2; ++r) { const int m = m0r + r * NGW; if (m < M) { const int b = m >> 12;
                        const float rstd2 = rsqrtf(s[r] * (1.f / D) + EPS);
                        const float* md1 = MOD + (size_t)(1 * 4 + b) * 3072;
                        u32x2* o8 = (u32x2*)(H + (size_t)m * D) + lane;
#pragma unroll
                        for (int j = 0; j < 4; ++j) { const int col = lane * 4 + 256 * j;
                            const f32x4 g = *(const f32x4*)(args.in[I_GPRE] + 1024 + col), sh = *(const f32x4*)(md1 + col), sc = *(const f32x4*)(md1 + 1024 + col);
                            const f32x4 hh = v[r][j] * rstd2 * g * (sc + 1.0f) + sh;
                            u32x2 w; w.x = pk2(hh.x, hh.y); w.y = pk2(hh.z, hh.w); o8[64 * j] = w; } } }
                }
            }
        }
#if !MK_MULTI
        if (ph + 1 < args.ph_hi && !nobar) { unsigned ones2 = ~0u; asm volatile("" : "+s"(ones2));
            const int tid2 = wave0 * 64 + (int)__builtin_amdgcn_mbcnt_hi(ones2, __builtin_amdgcn_mbcnt_lo(ones2, 0u));
            xcd_barrier(xbar, tid2); }
#endif
    }
}

extern "C" void kernel_launch(void* const* d_in, const int* in_sizes, int n_in, void* d_out, int out_size, void* d_ws, size_t ws_size, hipStream_t stream) {
    static int grid = 0;
    if (grid == 0) {
        if (n_in != 19 || out_size != M * D || ws_size < WS_END) { fprintf(stderr, "kernel_launch: unexpected shapes (n_in %d out %d ws %zu)\n", n_in, out_size, ws_size); grid = -1; return; }
        int dev = 0, cus = 0, per_cu = 0;
        hipGetDevice(&dev);
        hipDeviceGetAttribute(&cus, hipDeviceAttributeMultiprocessorCount, dev);
        if (hipFuncSetAttribute((const void*)fwd_kernel, hipFuncAttributeMaxDynamicSharedMemorySize, LDS_BYTES) != hipSuccess) { fprintf(stderr, "kernel_launch: hipFuncSetAttribute failed\n"); grid = -1; return; }
        if (hipOccupancyMaxActiveBlocksPerMultiprocessor(&per_cu, (const void*)fwd_kernel, NTHR, LDS_BYTES) != hipSuccess || per_cu < 1) per_cu = 1;
        (void)hipGetLastError();
        grid = cus * per_cu;
        if (grid > 256) grid = 256;
    }
    if (grid < 0) return;
    (void)hipMemsetAsync((char*)d_ws + WS_BAR, 0, 16384, stream);
    Args a{};
    for (int i = 0; i < 19; ++i) a.in[i] = (const float*)d_in[i];
    a.out = (float*)d_out; a.ws = (unsigned char*)d_ws;
    int nph = 0;
    auto push = [&](int k, int l, int nobar) { a.prog[nph++] = (unsigned char)(k | (l << 4) | (nobar << 7)); if (k == REPK) for (int r = 0; r < REPN; ++r) a.prog[nph++] = (unsigned char)(k | (l << 4) | (REPDRY << 6) | (nobar << 7)); };
    push(0, 0, 0); push(1, 0, 0);
    for (int l = 0; l < 2; ++l) { push(2, l, 0); push(3, l, 1); push(10, l, 0); push(5, l, 1); push(11, l, 1); push(12, l, 1); push(13, l, 0); push(15, l, 0); push(8, l, 0); push(9, l, 0); }
    if (REPK == 14) for (int r = 0; r < REPN; ++r) a.prog[nph++] = 14;
#if MK_MULTI
    for (int ph = 0; ph < nph; ++ph) { a.ph_lo = ph; a.ph_hi = ph + 1; hipLaunchKernelGGL(fwd_kernel, dim3(grid), dim3(NTHR), LDS_BYTES, stream, a); }
#else
    a.ph_lo = 0; a.ph_hi = nph;
    void* kargs[] = {&a};
    hipError_t e = hipLaunchCooperativeKernel((const void*)fwd_kernel, dim3(grid), dim3(NTHR), kargs, LDS_BYTES, stream);
    if (e != hipSuccess) fprintf(stderr, "cooperative launch failed: %s (grid %d)\n", hipGetErrorString(e), grid);
#endif
}
```
